# Optimizing an MI355X kernel written in HIP

```python
import jax, jax.numpy as jnp
from jax import lax
import numpy as np

D_MODEL = 1024
BATCH = 32
SEQ = 2048
DEPTH = 1

SB_HEAD_DIM = 64
SB_WIDTH = D_MODEL // 2
SB_HEADS = SB_WIDTH // SB_HEAD_DIM
GLA_HEADS = 4
GLA_WIDTH = D_MODEL - SB_WIDTH
GLA_DV = GLA_WIDTH // GLA_HEADS
GLA_DK = GLA_DV // 2
GLA_KEY_WIDTH = GLA_HEADS * GLA_DK
GLA_GATE_RANK = 16
GLA_GATE_NORMALIZER = 16.0
GLA_CHUNK = 64
Q_BLOCK = 128
D_FF = 2816
CONV_WIDTH = 3
EPS = 1e-6

IN_SPLITS = (SB_WIDTH, SB_WIDTH, SB_WIDTH,
             GLA_KEY_WIDTH, GLA_KEY_WIDTH, GLA_WIDTH,
             GLA_GATE_RANK, GLA_WIDTH)
IN_COLS = sum(IN_SPLITS)

kernel_name = "hybrid_stickbreak_gla_convffn"


def rms_norm(x, g):
    xf = x.astype(jnp.float32)
    y = xf * lax.rsqrt(jnp.mean(xf * xf, axis=-1, keepdims=True) + EPS)
    return (y * g.astype(jnp.float32)).astype(x.dtype)


def head_rms_norm(o, g):
    B, H, S, d = o.shape
    of = o.astype(jnp.float32)
    of = of * lax.rsqrt(jnp.mean(of * of, axis=-1, keepdims=True) + EPS)
    of = jnp.transpose(of, (0, 2, 1, 3)).reshape(B, S, H * d)
    return (of * g.astype(jnp.float32)).astype(o.dtype)


def to_heads(t, n_heads):
    B, S, W = t.shape
    return jnp.transpose(t.reshape(B, S, n_heads, W // n_heads), (0, 2, 1, 3))


def stick_breaking_attention(q, k, v):
    B, H, S, d = q.shape
    scale = d ** -0.5
    outs = []
    for i in range(S // Q_BLOCK):
        q0 = i * Q_BLOCK
        kn = q0 + Q_BLOCK
        z = jnp.einsum('bhqd,bhkd->bhqk', q[:, :, q0:kn], k[:, :, :kn]).astype(jnp.float32) * scale
        t_idx = q0 + jnp.arange(Q_BLOCK)[:, None]
        s_idx = jnp.arange(kn)[None, :]
        strict = s_idx < t_idx
        log1m = jnp.where(strict, -jax.nn.softplus(z), 0.0)
        after = lax.cumsum(log1m, axis=3, reverse=True) - log1m
        w = jnp.where(strict, jnp.exp(jax.nn.log_sigmoid(z) + after), 0.0)
        outs.append(jnp.einsum('bhqk,bhkd->bhqd', w.astype(v.dtype), v[:, :, :kn]))
    return jnp.concatenate(outs, axis=2)


def gla_chunked(q, k, v, log_a):
    B, H, S, dk = q.shape
    dv = v.shape[-1]
    C = GLA_CHUNK
    N = S // C
    f32 = jnp.float32
    qf = q.astype(f32).reshape(B, H, N, C, dk) * (dk ** -0.5)
    kf = k.astype(f32).reshape(B, H, N, C, dk)
    vf = v.astype(f32).reshape(B, H, N, C, dv)
    b = jnp.cumsum(log_a.astype(f32).reshape(B, H, N, C, dk), axis=3)
    b_last = b[:, :, :, -1:, :]
    q_dec = qf * jnp.exp(b)
    k_inv = kf * jnp.exp(-b)
    k_end = kf * jnp.exp(b_last - b)
    causal = jnp.tril(jnp.ones((C, C), dtype=f32))
    attn = jnp.einsum('bhnik,bhnjk->bhnij', q_dec, k_inv) * causal
    o_intra = jnp.einsum('bhnij,bhnjv->bhniv', attn, vf)
    chunk_kv = jnp.einsum('bhnck,bhncv->bhnkv', k_end, vf)
    decay = jnp.exp(b_last[:, :, :, 0, :])

    def step(state, inp):
        kv_n, dec_n = inp
        return dec_n[..., None] * state + kv_n, state

    init = jnp.zeros((B, H, dk, dv), dtype=f32)
    _, prev = lax.scan(step, init, (jnp.moveaxis(chunk_kv, 2, 0), jnp.moveaxis(decay, 2, 0)))
    prev = jnp.moveaxis(prev, 0, 2)
    o_inter = jnp.einsum('bhnck,bhnkv->bhncv', q_dec, prev)
    return (o_intra + o_inter).reshape(B, H, S, dv).astype(v.dtype)


def causal_depthwise_conv(u, w, bias):
    S = u.shape[1]
    up = jnp.pad(u, ((0, 0), (CONV_WIDTH - 1, 0), (0, 0)))
    out = bias
    for tap in range(CONV_WIDTH):
        out = out + w[tap] * up[:, tap:tap + S]
    return out


def setup_inputs(seed: int = 0) -> dict:
    key = jax.random.key(seed)
    ks = jax.random.split(key, 16)
    nrm = lambda k, shape, s: jax.random.normal(k, shape, dtype=jnp.float32) * s
    gain = lambda k, shape: 1.0 + 0.02 * jax.random.normal(k, shape, dtype=jnp.float32)
    return {
        "x": nrm(ks[0], (BATCH, SEQ, D_MODEL), 1.0),
        "attn_norm_g": gain(ks[1], (DEPTH, D_MODEL)),
        "w_in": nrm(ks[2], (DEPTH, D_MODEL, IN_COLS), D_MODEL ** -0.5),
        "w_gate_up": nrm(ks[3], (DEPTH, GLA_GATE_RANK, GLA_KEY_WIDTH), GLA_GATE_RANK ** -0.5),
        "b_gate_up": nrm(ks[4], (DEPTH, GLA_KEY_WIDTH), 0.1),
        "sb_out_g": gain(ks[5], (DEPTH, SB_WIDTH)),
        "gla_out_g": gain(ks[6], (DEPTH, GLA_WIDTH)),
        "w_out": nrm(ks[7], (DEPTH, D_MODEL, D_MODEL), D_MODEL ** -0.5),
        "ffn_norm_g": gain(ks[8], (DEPTH, D_MODEL)),
        "w_ffn_up": nrm(ks[9], (DEPTH, D_MODEL, 2 * D_FF), D_MODEL ** -0.5),
        "conv_w": nrm(ks[10], (DEPTH, CONV_WIDTH, 2 * D_FF), CONV_WIDTH ** -0.5),
        "conv_b": nrm(ks[11], (DEPTH, 2 * D_FF), 0.01),
        "w_ffn_down": nrm(ks[12], (DEPTH, D_FF, D_MODEL), D_FF ** -0.5),
        "final_norm_g": gain(ks[13], (D_MODEL,)),
    }


def reference(x, attn_norm_g, w_in, w_gate_up, b_gate_up, sb_out_g, gla_out_g, w_out,
              ffn_norm_g, w_ffn_up, conv_w, conv_b, w_ffn_down, final_norm_g):
    offsets = list(np.cumsum(IN_SPLITS)[:-1])
    for l in range(DEPTH):
        h = rms_norm(x, attn_norm_g[l])
        proj = h @ w_in[l]
        sb_q, sb_k, sb_v, g_q, g_k, g_v, g_lr, g_og = jnp.split(proj, offsets, axis=-1)

        o_sb = stick_breaking_attention(to_heads(sb_q, SB_HEADS), to_heads(sb_k, SB_HEADS),
                                        to_heads(sb_v, SB_HEADS))
        o_sb = head_rms_norm(o_sb, sb_out_g[l])

        log_a = jax.nn.log_sigmoid((g_lr @ w_gate_up[l] + b_gate_up[l]).astype(jnp.float32)) / GLA_GATE_NORMALIZER
        o_gla = gla_chunked(to_heads(g_q, GLA_HEADS), to_heads(g_k, GLA_HEADS),
                            to_heads(g_v, GLA_HEADS), to_heads(log_a, GLA_HEADS))
        o_gla = head_rms_norm(o_gla, gla_out_g[l]) * jax.nn.silu(g_og)

        x = x + jnp.concatenate([o_sb, o_gla], axis=-1) @ w_out[l]

        h = rms_norm(x, ffn_norm_g[l])
        u = causal_depthwise_conv(h @ w_ffn_up[l], conv_w[l], conv_b[l])
        a, val = jnp.split(u, 2, axis=-1)
        x = x + (jax.nn.silu(a) * val) @ w_ffn_down[l]
    return rms_norm(x, final_norm_g)
```

```cpp
#include <hip/hip_runtime.h>
#include <hip/hip_cooperative_groups.h>
#include <cstdio>
#include <cstdint>
namespace cg = cooperative_groups;

#define DI __device__ __forceinline__
#define LAS __attribute__((address_space(3)))
typedef unsigned short bf16_t;
typedef short bf16x8 __attribute__((ext_vector_type(8)));
typedef short s16x4 __attribute__((ext_vector_type(4)));
typedef float f32x4 __attribute__((ext_vector_type(4)));
typedef float f32x2 __attribute__((ext_vector_type(2)));
typedef float f32x16 __attribute__((ext_vector_type(16)));
typedef unsigned u32x4 __attribute__((ext_vector_type(4)));
typedef unsigned u32x2 __attribute__((ext_vector_type(2)));
typedef __bf16 bf16x2_t __attribute__((ext_vector_type(2)));

constexpr int T = 65536, SEQ = 2048, NB = 32, D = 1024;
constexpr int PP = 3072;
constexpr int Q_OFF = 0, K_OFF = 512, V_OFF = 1024, GQ_OFF = 1536, GK_OFF = 1792, GV_OFF = 2048, OG_OFF = 2560;
constexpr int N1 = 3328;
constexpr int DFF = 2816, NU = 5632;
constexpr float EPS = 1e-6f;
constexpr float LOG2E = 1.4426950408889634f;
constexpr float QSCALE = 0.125f * LOG2E;

constexpr size_t MiB = 1u << 20;
constexpr size_t WS_CTL = 0;
constexpr size_t WS_SSQ2 = 256 * 1024, WS_SSQ3 = 512 * 1024, WS_RSTD1 = 768 * 1024;
constexpr size_t WS_QK0 = 1 * MiB;
constexpr size_t WS_WIN = 2 * MiB, WS_WOUT = 9 * MiB, WS_WUP = 11 * MiB, WS_WDN = 22 * MiB;
constexpr size_t WS_HHEAD = 28 * MiB, WS_HTAIL = 39 * MiB;
constexpr size_t WS_XCH = 50 * MiB;
constexpr size_t WS_XB = 64 * MiB;
constexpr size_t WS_PROJ = 192 * MiB;
constexpr size_t WS_B2 = 576 * MiB;
constexpr size_t WS_OCAT = 640 * MiB;
constexpr size_t WS_G = 192 * MiB;
constexpr size_t WS_END = 768 * MiB;

constexpr int GEMM_LDS = 131072;
constexpr int HALO_OFF = GEMM_LDS;
constexpr int MISC_OFF = HALO_OFF + 10240;
constexpr int LDS_BYTES = 147456;

DI unsigned cvt_pk_bf16(float lo, float hi) { f32x2 v = {lo, hi}; bf16x2_t b = __builtin_convertvector(v, bf16x2_t); return __builtin_bit_cast(unsigned, b); }
DI float bf2f(unsigned short v) { return __uint_as_float(((unsigned)v) << 16); }
DI float bflo(unsigned w) { return __uint_as_float(w << 16); }
DI float bfhi(unsigned w) { return __uint_as_float(w & 0xffff0000u); }
DI float fexp2(float x) { return __builtin_amdgcn_exp2f(x); }
DI float flog2(float x) { return __builtin_amdgcn_logf(x); }
DI float wave_sum(float v) {
#pragma unroll
    for (int o = 1; o < 64; o <<= 1) v += __shfl_xor(v, o);
    return v;
}
template <int CTRL, bool BC> DI float dppf(float old, float src) {
    return __int_as_float(__builtin_amdgcn_update_dpp(__float_as_int(old), __float_as_int(src), CTRL, 0xf, 0xf, BC));
}

namespace pg8 {
constexpr int BM = 256, BK = 64, HALF = 128, HTB = HALF * BK * 2, STAGE_BYTES = 8 * HTB, NXCD = 8, WGM = 8;
DI int lds_byte(int r, int c) { const int st = (r >> 4) * 2 + (c >> 5), rr = r & 15, cc = c & 31, ob = rr * 64 + cc * 2; return st * 1024 + (ob ^ (((ob >> 9) & 1) << 5)); }
DI void stage_rc(int b, int& R, int& C) { const int st = b / 1024, sb = b % 1024, swz = sb ^ (((sb >> 9) & 1) << 5); R = (st >> 1) * 16 + swz / 64; C = (st & 1) * 32 + (swz % 64) / 2; }
DI int perm32(int rho) { const int n = rho >> 4, i = rho & 15; return 8 * (i >> 2) + 4 * n + (i & 3); }
struct Unit { int pm, pn; };
struct Gemm { const bf16_t* A; const bf16_t* Bt; int M, N, K; };
struct StaticOrder {
    int nM, nN, nwg, G, c;
    DI void init(int M, int N, int G_, int c_) { nM = M / BM; nN = N / BM; nwg = nM * nN; G = G_; c = c_; }
    DI bool next(int i, Unit& u) const {
        const long L = (long)i * G + c; if (L >= nwg) return false;
        int wgid = (int)L; { const int q = nwg / NXCD, r = nwg % NXCD, xcd = wgid % NXCD, off = wgid / NXCD; wgid = (xcd < r ? xcd * (q + 1) : r * (q + 1) + (xcd - r) * q) + off; }
        const int nig = WGM * nN, gid = wgid / nig, fm = gid * WGM, gsz = (nM - fm) < WGM ? (nM - fm) : WGM;
        u.pm = fm + ((wgid % nig) % gsz); u.pn = (wgid % nig) / gsz; return true;
    }
};

template <class Epi, class Sched, bool ALIGN_EPI = true, bool SP2 = true>
DI void gemm_phase(LAS unsigned char* lds, const Gemm g, const Sched& S, const Epi& E) {
    const int tid = threadIdx.x, wid = __builtin_amdgcn_readfirstlane(tid >> 6), lane = tid & 63, wr = wid >> 2, wc = wid & 3, fr = lane & 15, fq = lane >> 4;
    const int K = g.K, nt = K / BK;
    unsigned voffA[2], voffB[2];
#pragma unroll
    for (int i = 0; i < 2; ++i) { int R, C; stage_rc(tid * 16 + i * 8192, R, C); const int Rb = Epi::PERM ? ((R & ~31) + perm32(R & 31)) : R;
        voffA[i] = (unsigned)(R * K + C) * 2u; voffB[i] = (unsigned)(Rb * K + C) * 2u; }
    const size_t kstep = (size_t)(BK * 2);
    const size_t hstep = (size_t)HALF * K * 2;
    const size_t tstep = 2 * hstep;
    const unsigned ldsw = (unsigned)wid * 1024u;
    const int aoff = lds_byte(wr * 64 + fr, fq * 8), boff = lds_byte(wc * 32 + fr, fq * 8);
#define PG8_SA(b, h) (((b) * 2 + (h)) * HTB)
#define PG8_SB(b, h) ((4 + (b) * 2 + (h)) * HTB)
#define PG8_STAGE(bufoff, gbase, voff) do { _Pragma("unroll") for (int _i = 0; _i < 2; ++_i) \
        __builtin_amdgcn_global_load_lds((const unsigned*)((const char*)(gbase) + (voff)[_i]), (LAS unsigned*)(lds + (bufoff) + ldsw + _i * 8192), 16, 0, 0); } while (0)
#define PG8_LDA(dst, b, h) do { _Pragma("unroll") for (int m = 0; m < 4; ++m) _Pragma("unroll") for (int k = 0; k < 2; ++k) dst[m][k] = *(const LAS bf16x8*)(lds + PG8_SA(b, h) + aoff + m * 2048 + k * 1024); } while (0)
#define PG8_LDB(dst, b, h) do { _Pragma("unroll") for (int n = 0; n < 2; ++n) _Pragma("unroll") for (int k = 0; k < 2; ++k) dst[n][k] = *(const LAS bf16x8*)(lds + PG8_SB(b, h) + boff + n * 2048 + k * 1024); } while (0)
#define PG8_MMA(ai, bj, At, Bt) do { __builtin_amdgcn_s_setprio(1); _Pragma("unroll") for (int m = 0; m < 4; ++m) _Pragma("unroll") for (int n = 0; n < 2; ++n) _Pragma("unroll") for (int k = 0; k < 2; ++k) \
        acc[ai][bj][m][n] = __builtin_amdgcn_mfma_f32_16x16x32_bf16(Bt[n][k], At[m][k], acc[ai][bj][m][n], 0, 0, 0); __builtin_amdgcn_s_setprio(0); } while (0)
#define PG8_WAIT_V(n) asm volatile("s_waitcnt vmcnt(" #n ")" ::: "memory")
#define PG8_WAIT_L(n) asm volatile("s_waitcnt lgkmcnt(" #n ")" ::: "memory")
#define PG8_BAR __builtin_amdgcn_s_barrier()
#define PG8_SCHED __builtin_amdgcn_sched_barrier(0)
    Unit cur, nxt; int ui = 0;
    if (!S.next(0, cur)) return;
    f32x4 acc[2][2][4][2];
#pragma unroll
    for (int a = 0; a < 2; ++a)
#pragma unroll
        for (int b = 0; b < 2; ++b)
#pragma unroll
            for (int m = 0; m < 4; ++m)
#pragma unroll
                for (int n = 0; n < 2; ++n) acc[a][b][m][n] = (f32x4){0.f, 0.f, 0.f, 0.f};
    bf16x8 At[4][2], B0[2][2], B1[2][2];
    const char* cA = (const char*)g.A + (size_t)cur.pm * tstep; const char* cB = (const char*)g.Bt + (size_t)cur.pn * tstep;
    if constexpr (SP2) {
        PG8_STAGE(PG8_SB(0, 0), cB, voffB); PG8_STAGE(PG8_SB(0, 1), cB + hstep, voffB); PG8_STAGE(PG8_SA(0, 0), cA, voffA); PG8_STAGE(PG8_SA(0, 1), cA + hstep, voffA);
        if (wr == 1) PG8_BAR;
        PG8_WAIT_V(2); PG8_BAR;
        PG8_STAGE(PG8_SB(1, 0), cB + kstep, voffB); PG8_STAGE(PG8_SA(1, 0), cA + kstep, voffA); PG8_STAGE(PG8_SB(1, 1), cB + hstep + kstep, voffB);
        PG8_WAIT_V(6); PG8_BAR;
    } else {
        PG8_STAGE(PG8_SB(0, 0), cB, voffB); PG8_STAGE(PG8_SA(0, 0), cA, voffA); PG8_STAGE(PG8_SB(0, 1), cB + hstep, voffB); PG8_STAGE(PG8_SA(0, 1), cA + hstep, voffA);
        if (wr == 1) PG8_BAR;
        PG8_WAIT_V(4); PG8_BAR;
        PG8_STAGE(PG8_SB(1, 0), cB + kstep, voffB); PG8_STAGE(PG8_SA(1, 0), cA + kstep, voffA); PG8_STAGE(PG8_SB(1, 1), cB + hstep + kstep, voffB);
        PG8_WAIT_V(6); PG8_BAR;
    }
    for (;;) {
        const bool has_next = S.next(ui + 1, nxt);
        const char* nA = has_next ? (const char*)g.A + (size_t)nxt.pm * tstep : cA; const char* nB = has_next ? (const char*)g.Bt + (size_t)nxt.pn * tstep : cB;
        for (int t = 0; t < nt; t += 2) {
            const bool last = (t == nt - 2);
            const char* a1 = cA + (size_t)(t + 1) * kstep;
            const char* a2 = last ? nA : cA + (size_t)(t + 2) * kstep; const char* b2 = last ? nB : cB + (size_t)(t + 2) * kstep;
            const char* a3 = a2 + kstep; const char* b3 = b2 + kstep;
            if constexpr (SP2) {
            PG8_LDB(B0, 0, 0); PG8_LDB(B1, 0, 1); PG8_SCHED; PG8_LDA(At, 0, 0); PG8_STAGE(PG8_SA(1, 1), a1 + hstep, voffA);
            PG8_WAIT_V(8); PG8_WAIT_L(0); PG8_BAR; PG8_MMA(0, 0, At, B0); PG8_MMA(0, 1, At, B1); PG8_BAR; PG8_SCHED;
            PG8_LDA(At, 0, 1); PG8_STAGE(PG8_SB(0, 0), b2, voffB); PG8_STAGE(PG8_SB(0, 1), b2 + hstep, voffB); PG8_STAGE(PG8_SA(0, 0), a2, voffA);
            PG8_WAIT_V(8); PG8_WAIT_L(0); PG8_BAR; PG8_MMA(1, 0, At, B0); PG8_MMA(1, 1, At, B1); PG8_BAR; PG8_SCHED;
            PG8_LDB(B0, 1, 0); PG8_LDB(B1, 1, 1); PG8_SCHED; PG8_LDA(At, 1, 0); PG8_STAGE(PG8_SA(0, 1), a2 + hstep, voffA);
            PG8_WAIT_V(8); PG8_WAIT_L(0); PG8_BAR; PG8_MMA(0, 0, At, B0); PG8_MMA(0, 1, At, B1); PG8_BAR; PG8_SCHED;
            PG8_LDA(At, 1, 1); PG8_STAGE(PG8_SB(1, 0), b3, voffB); PG8_STAGE(PG8_SB(1, 1), b3 + hstep, voffB); PG8_STAGE(PG8_SA(1, 0), a3, voffA);
            PG8_WAIT_V(8); PG8_WAIT_L(0); PG8_BAR; PG8_MMA(1, 0, At, B0); PG8_MMA(1, 1, At, B1); PG8_BAR; PG8_SCHED;
            } else {
            PG8_LDB(B0, 0, 0); PG8_SCHED; PG8_LDA(At, 0, 0); PG8_STAGE(PG8_SA(1, 1), a1 + hstep, voffA);
            PG8_WAIT_L(8); PG8_BAR; PG8_WAIT_L(0); PG8_MMA(0, 0, At, B0); PG8_BAR; PG8_SCHED;
            PG8_LDB(B1, 0, 1); PG8_STAGE(PG8_SB(0, 0), b2, voffB);
            PG8_BAR; PG8_WAIT_L(0); PG8_MMA(0, 1, At, B1); PG8_BAR;
            PG8_LDA(At, 0, 1); PG8_STAGE(PG8_SA(0, 0), a2, voffA);
            PG8_BAR; PG8_WAIT_L(0); PG8_MMA(1, 0, At, B0); PG8_BAR; PG8_SCHED;
            PG8_STAGE(PG8_SB(0, 1), b2 + hstep, voffB);
            PG8_WAIT_V(6); PG8_BAR; PG8_MMA(1, 1, At, B1); PG8_BAR;
            PG8_LDB(B0, 1, 0); PG8_SCHED; PG8_LDA(At, 1, 0); PG8_STAGE(PG8_SA(0, 1), a2 + hstep, voffA);
            PG8_WAIT_L(8); PG8_BAR; PG8_WAIT_L(0); PG8_MMA(0, 0, At, B0); PG8_BAR; PG8_SCHED;
            PG8_LDB(B1, 1, 1); PG8_STAGE(PG8_SB(1, 0), b3, voffB);
            PG8_BAR; PG8_WAIT_L(0); PG8_MMA(0, 1, At, B1); PG8_BAR;
            PG8_LDA(At, 1, 1); PG8_STAGE(PG8_SA(1, 0), a3, voffA);
            PG8_BAR; PG8_WAIT_L(0); PG8_MMA(1, 0, At, B0); PG8_BAR; PG8_SCHED;
            PG8_STAGE(PG8_SB(1, 1), b3 + hstep, voffB);
            PG8_WAIT_V(6); PG8_BAR; PG8_MMA(1, 1, At, B1); PG8_BAR;
            }
        }
        if constexpr (ALIGN_EPI) { if (wr == 0) PG8_BAR; }
        E(acc, cur, wr, wc, fr, fq);
        if (!has_next) break;
#pragma unroll
        for (int a = 0; a < 2; ++a)
#pragma unroll
            for (int b = 0; b < 2; ++b)
#pragma unroll
                for (int m = 0; m < 4; ++m)
#pragma unroll
                    for (int n = 0; n < 2; ++n) acc[a][b][m][n] = (f32x4){0.f, 0.f, 0.f, 0.f};
        cur = nxt; cA = nA; cB = nB; ++ui;
        if constexpr (ALIGN_EPI) { if (wr == 1) PG8_BAR; }
    }
    PG8_WAIT_V(0);
    if constexpr (!ALIGN_EPI) { if (wr == 0) PG8_BAR; }
    PG8_BAR;
#undef PG8_SA
#undef PG8_SB
#undef PG8_STAGE
#undef PG8_LDA
#undef PG8_LDB
#undef PG8_MMA
#undef PG8_WAIT_V
#undef PG8_WAIT_L
#undef PG8_BAR
#undef PG8_SCHED
}
}
using pg8::Unit;
typedef f32x4 Acc[2][2][4][2];

struct Epi1 {
    static constexpr bool PERM = true;
    bf16_t* proj; float* b2; const float* rstd; const float* bgate;
    DI void operator()(Acc& acc, const Unit& u, int wr, int wc, int fr, int fq) const {
        const int row0 = u.pm * 256 + wr * 64 + fr;
        if (u.pn < 12) {
            const int col0 = u.pn * 256 + wc * 32 + 8 * fq;
#pragma unroll
            for (int ai = 0; ai < 2; ++ai)
#pragma unroll
                for (int m = 0; m < 4; ++m) {
                    const int row = row0 + ai * 128 + m * 16; const float sc = rstd[row];
                    bf16_t* rowp = proj + (size_t)row * PP + col0;
#pragma unroll
                    for (int bj = 0; bj < 2; ++bj) { const f32x4 v0 = acc[ai][bj][m][0] * sc, v1 = acc[ai][bj][m][1] * sc;
                        u32x4 w; w.x = cvt_pk_bf16(v0[0], v0[1]); w.y = cvt_pk_bf16(v0[2], v0[3]); w.z = cvt_pk_bf16(v1[0], v1[1]); w.w = cvt_pk_bf16(v1[2], v1[3]);
                        *(u32x4*)(rowp + bj * 128) = w; }
                }
        } else {
            const int c0 = wc * 32 + 8 * fq;
            const int lane = threadIdx.x & 63;
#pragma unroll
            for (int ai = 0; ai < 2; ++ai) {
                float sc[4];
#pragma unroll
                for (int m = 0; m < 4; ++m) sc[m] = rstd[row0 + ai * 128 + m * 16];
#pragma unroll
                for (int bj = 0; bj < 2; ++bj)
#pragma unroll
                    for (int n = 0; n < 2; ++n) {
                        const int cc = c0 + 128 * bj + 4 * n;
                        const f32x4 bias = *(const f32x4*)(bgate + cc);
                        f32x4 carry = {0.f, 0.f, 0.f, 0.f};
#pragma unroll
                        for (int m = 0; m < 4; ++m) {
                            const f32x4 v = acc[ai][bj][m][n] * sc[m] + bias;
                            f32x4 la;
#pragma unroll
                            for (int c = 0; c < 4; ++c) {
                                const float x = v[c];
                                float l = fminf(x, 0.f) * LOG2E - flog2(1.f + fexp2(-fabsf(x) * LOG2E));
                                l *= (1.0f / 16.0f);
                                l += dppf<0x111, true>(0.f, l);
                                l += dppf<0x112, true>(0.f, l);
                                l += dppf<0x114, true>(0.f, l);
                                l += dppf<0x118, true>(0.f, l);
                                l += carry[c];
                                carry[c] = __shfl(l, (lane & 48) | 15);
                                la[c] = l;
                            }
                            *(f32x4*)(b2 + (size_t)(row0 + ai * 128 + m * 16) * 256 + cc) = la;
                        }
                    }
            }
        }
    }
};

template <bool WB> struct EpiRes {
    static constexpr bool PERM = true;
    const float* base; float* out; bf16_t* outb; float* ssq;
    DI void operator()(Acc& acc, const Unit& u, int wr, int wc, int fr, int fq) const {
        const int row0 = u.pm * 256 + wr * 64 + fr, col0 = u.pn * 256 + wc * 32 + 8 * fq;
#pragma unroll
        for (int ai = 0; ai < 2; ++ai)
#pragma unroll
            for (int m = 0; m < 4; ++m) {
                const int row = row0 + ai * 128 + m * 16; const size_t off = (size_t)row * D + col0; float s = 0.f;
#pragma unroll
                for (int bj = 0; bj < 2; ++bj) {
                    const f32x4 b0 = *(const f32x4*)(base + off + bj * 128), b1 = *(const f32x4*)(base + off + bj * 128 + 4);
                    const f32x4 v0 = acc[ai][bj][m][0] + b0, v1 = acc[ai][bj][m][1] + b1;
                    *(f32x4*)(out + off + bj * 128) = v0; *(f32x4*)(out + off + bj * 128 + 4) = v1;
                    s += (v0[0] * v0[0] + v0[1] * v0[1]) + (v0[2] * v0[2] + v0[3] * v0[3]) + (v1[0] * v1[0] + v1[1] * v1[1]) + (v1[2] * v1[2] + v1[3] * v1[3]);
                    if (WB) { u32x4 w; w.x = cvt_pk_bf16(v0[0], v0[1]); w.y = cvt_pk_bf16(v0[2], v0[3]); w.z = cvt_pk_bf16(v1[0], v1[1]); w.w = cvt_pk_bf16(v1[2], v1[3]);
                        *(u32x4*)(outb + off + bj * 128) = w; }
                }
                s += __shfl_xor(s, 16); s += __shfl_xor(s, 32);
                if (fq == 0) atomicAdd(ssq + row, s);
            }
    }
};

DI f32x4 rot_prev(const f32x4& cur, const f32x4& prev, int fr, int which) {
    f32x4 r;
#pragma unroll
    for (int c = 0; c < 4; ++c) {
        if (which == 1) { const float t = dppf<0x10F, true>(0.f, prev[c]); r[c] = dppf<0x111, false>(t, cur[c]); }
        else            { const float t = dppf<0x10E, true>(0.f, prev[c]); r[c] = dppf<0x112, false>(t, cur[c]); }
    }
    return r;
}
struct Epi3 {
    static constexpr bool PERM = true;
    bf16_t* g; const float* ssq2; const float* convw; const float* convb; float* hhead; float* htail; LAS float* halo;
    DI void operator()(Acc& acc, const Unit& u, int wr, int wc, int fr, int fq) const {
        const int row0 = u.pm * 256 + wr * 64 + fr;
        const int cl = wc * 32 + 8 * fq;
#pragma unroll
        for (int ai = 0; ai < 2; ++ai)
#pragma unroll
            for (int m = 0; m < 4; ++m) { const float sc = 1.0f / sqrtf(ssq2[row0 + ai * 128 + m * 16] * (1.0f / D) + EPS);
#pragma unroll
                for (int bj = 0; bj < 2; ++bj) { acc[ai][bj][m][0] *= sc; acc[ai][bj][m][1] *= sc; } }
        if (fr >= 14) {
#pragma unroll
            for (int ai = 0; ai < 2; ++ai) {
                LAS float* hp = halo + ((2 * ai + wr + 1) * 2 + (fr - 14)) * 256 + cl;
#pragma unroll
                for (int bj = 0; bj < 2; ++bj) { *(LAS f32x4*)(hp + bj * 128) = acc[ai][bj][3][0]; *(LAS f32x4*)(hp + bj * 128 + 4) = acc[ai][bj][3][1]; }
            }
            if (wr == 0) { LAS float* hp = halo + (fr - 14) * 256 + cl; const f32x4 z = {0.f, 0.f, 0.f, 0.f};
                *(LAS f32x4*)(hp) = z; *(LAS f32x4*)(hp + 4) = z; *(LAS f32x4*)(hp + 128) = z; *(LAS f32x4*)(hp + 132) = z; }
            if (wr == 1) { float* tp = htail + ((size_t)u.pm * 2 + (fr - 14)) * NU + u.pn * 256 + cl;
#pragma unroll
                for (int bj = 0; bj < 2; ++bj) { *(f32x4*)(tp + bj * 128) = acc[1][bj][3][0]; *(f32x4*)(tp + bj * 128 + 4) = acc[1][bj][3][1]; } }
        }
        if (fr < 2 && wr == 0) { float* tp = hhead + ((size_t)u.pm * 2 + fr) * NU + u.pn * 256 + cl;
#pragma unroll
            for (int bj = 0; bj < 2; ++bj) { *(f32x4*)(tp + bj * 128) = acc[0][bj][0][0]; *(f32x4*)(tp + bj * 128 + 4) = acc[0][bj][0][1]; } }
        asm volatile("s_waitcnt lgkmcnt(0)" ::: "memory"); __builtin_amdgcn_s_barrier(); asm volatile("" ::: "memory");
        const int ch = u.pn * 128 + cl;
#pragma unroll
        for (int n = 0; n < 2; ++n) {
            const f32x4 wa0 = *(const f32x4*)(convw + ch + 4 * n), wa1 = *(const f32x4*)(convw + NU + ch + 4 * n), wa2 = *(const f32x4*)(convw + 2 * NU + ch + 4 * n), ba = *(const f32x4*)(convb + ch + 4 * n);
            const f32x4 wv0 = *(const f32x4*)(convw + DFF + ch + 4 * n), wv1 = *(const f32x4*)(convw + NU + DFF + ch + 4 * n), wv2 = *(const f32x4*)(convw + 2 * NU + DFF + ch + 4 * n), bv = *(const f32x4*)(convb + DFF + ch + 4 * n);
#pragma unroll
            for (int ai = 0; ai < 2; ++ai) {
                asm volatile("" ::: "memory"); __builtin_amdgcn_sched_barrier(0);
                f32x4 pa = {0.f, 0.f, 0.f, 0.f}, pv = {0.f, 0.f, 0.f, 0.f};
                if (fr >= 14) { const LAS float* hp = halo + ((2 * ai + wr) * 2 + (fr - 14)) * 256 + cl + 4 * n; pa = *(const LAS f32x4*)hp; pv = *(const LAS f32x4*)(hp + 128); }
#pragma unroll
                for (int m = 0; m < 4; ++m) {
                    asm volatile("" : "+v"(acc[ai][0][m][n]), "+v"(acc[ai][1][m][n]), "+v"(pa), "+v"(pv));
                    const f32x4 ca = acc[ai][0][m][n], cv = acc[ai][1][m][n];
                    const f32x4 a1 = rot_prev(ca, pa, fr, 1), a2 = rot_prev(ca, pa, fr, 2);
                    const f32x4 v1 = rot_prev(cv, pv, fr, 1), v2 = rot_prev(cv, pv, fr, 2);
                    const f32x4 a = ba + wa0 * a2 + wa1 * a1 + wa2 * ca;
                    const f32x4 v = bv + wv0 * v2 + wv1 * v1 + wv2 * cv;
                    f32x4 o;
#pragma unroll
                    for (int c = 0; c < 4; ++c) o[c] = a[c] * v[c] * __builtin_amdgcn_rcpf(1.f + fexp2(-a[c] * LOG2E));
                    acc[ai][0][m][n] = o; pa = ca; pv = cv;
                    asm volatile("" : "+v"(acc[ai][0][m][n]));
                }
            }
        }
#pragma unroll
        for (int ai = 0; ai < 2; ++ai)
#pragma unroll
            for (int m = 0; m < 4; ++m) { const f32x4 v0 = acc[ai][0][m][0], v1 = acc[ai][0][m][1];
                u32x4 w; w.x = cvt_pk_bf16(v0[0], v0[1]); w.y = cvt_pk_bf16(v0[2], v0[3]); w.z = cvt_pk_bf16(v1[0], v1[1]); w.w = cvt_pk_bf16(v1[2], v1[3]);
                *(u32x4*)(g + (size_t)(row0 + ai * 128 + m * 16) * DFF + ch) = w; }
    }
};


struct Epi4F {
    static constexpr bool PERM = true;
    const float* base; float* out; const float* gfin; float* xbuf; unsigned* cnt; LAS float* scr;
    DI void operator()(Acc& acc, const Unit& u, int wr, int wc, int fr, int fq) const {
        const int tid = threadIdx.x, lane = tid & 63;
        const int row0 = u.pm * 256 + wr * 64 + fr, col0 = u.pn * 256 + wc * 32 + 8 * fq;
        LAS float* part = scr; LAS float* S = scr + 1024;
#pragma unroll
        for (int ai = 0; ai < 2; ++ai)
#pragma unroll
            for (int m = 0; m < 4; ++m) {
                const size_t off = (size_t)(row0 + ai * 128 + m * 16) * D + col0; float s = 0.f;
#pragma unroll
                for (int bj = 0; bj < 2; ++bj) {
                    const f32x4 b0 = *(const f32x4*)(base + off + bj * 128), b1 = *(const f32x4*)(base + off + bj * 128 + 4);
                    const f32x4 v0 = acc[ai][bj][m][0] + b0, v1 = acc[ai][bj][m][1] + b1;
                    acc[ai][bj][m][0] = v0; acc[ai][bj][m][1] = v1;
                    s += (v0[0] * v0[0] + v0[1] * v0[1]) + (v0[2] * v0[2] + v0[3] * v0[3]) + (v1[0] * v1[0] + v1[1] * v1[1]) + (v1[2] * v1[2] + v1[3] * v1[3]);
                }
                s += __shfl_xor(s, 16); s += __shfl_xor(s, 32);
                if (fq == 0) part[wc * 256 + ai * 128 + wr * 64 + m * 16 + fr] = s;
                if (m & 1) asm volatile("" ::: "memory");
            }
        asm volatile("s_waitcnt lgkmcnt(0)" ::: "memory"); __builtin_amdgcn_s_barrier(); asm volatile("" ::: "memory");
        unsigned* cw = cnt + 64 * u.pm;
        if (tid < 256) {
            const float tot = (part[tid] + part[256 + tid]) + (part[512 + tid] + part[768 + tid]);
            __hip_atomic_store(xbuf + ((size_t)u.pm * 4 + u.pn) * 256 + tid, tot, __ATOMIC_RELAXED, __HIP_MEMORY_SCOPE_AGENT);
            asm volatile("s_waitcnt vmcnt(0)" ::: "memory");
            if (lane == 0) __hip_atomic_fetch_add(cw, 1u, __ATOMIC_RELAXED, __HIP_MEMORY_SCOPE_AGENT);
        }
        if (tid == 0) {
            unsigned spins = 0;
            while (__hip_atomic_load(cw, __ATOMIC_RELAXED, __HIP_MEMORY_SCOPE_AGENT) < 16u) { __builtin_amdgcn_s_sleep(2); if (++spins > (1u << 24)) break; }
            __builtin_amdgcn_fence(__ATOMIC_ACQUIRE, "agent");
        }
        asm volatile("s_waitcnt vmcnt(0) lgkmcnt(0)" ::: "memory"); __builtin_amdgcn_s_barrier(); asm volatile("" ::: "memory");
        if (tid < 256) {
            const float* sl = xbuf + (size_t)u.pm * 4 * 256 + tid;
            const float t = (__hip_atomic_load(sl, __ATOMIC_RELAXED, __HIP_MEMORY_SCOPE_AGENT) + __hip_atomic_load(sl + 256, __ATOMIC_RELAXED, __HIP_MEMORY_SCOPE_AGENT))
                          + (__hip_atomic_load(sl + 512, __ATOMIC_RELAXED, __HIP_MEMORY_SCOPE_AGENT) + __hip_atomic_load(sl + 768, __ATOMIC_RELAXED, __HIP_MEMORY_SCOPE_AGENT));
            S[tid] = 1.0f / sqrtf(t * (1.0f / D) + EPS);
        }
        asm volatile("s_waitcnt lgkmcnt(0)" ::: "memory"); __builtin_amdgcn_s_barrier(); asm volatile("" ::: "memory");
        f32x4 gv[2][2];
#pragma unroll
        for (int bj = 0; bj < 2; ++bj) { gv[bj][0] = *(const f32x4*)(gfin + col0 + bj * 128); gv[bj][1] = *(const f32x4*)(gfin + col0 + bj * 128 + 4); }
#pragma unroll
        for (int ai = 0; ai < 2; ++ai)
#pragma unroll
            for (int m = 0; m < 4; ++m) {
                const float rs = S[ai * 128 + wr * 64 + m * 16 + fr]; const size_t off = (size_t)(row0 + ai * 128 + m * 16) * D + col0;
#pragma unroll
                for (int bj = 0; bj < 2; ++bj) { *(f32x4*)(out + off + bj * 128) = acc[ai][bj][m][0] * rs * gv[bj][0]; *(f32x4*)(out + off + bj * 128 + 4) = acc[ai][bj][m][1] * rs * gv[bj][1]; }
            }
    }
};


#define RLX_AGENT __ATOMIC_RELAXED, __HIP_MEMORY_SCOPE_AGENT
#define XB_TMO      128
#define XB_XCNT(j)  (256  + 64 * (j))
#define XB_XSUB(j)  (1280 + 64 * (j))
#define XB_XGEN(j)  (2304 + 64 * (j))
#define XB_TOP      3328
#define XB_TOPGEN   3392
#define XCD_BAR_WORDS 3456
#define XB_SPIN_CAP (1u << 18)

__device__ __forceinline__ unsigned xb_ld(unsigned* p)              { return __hip_atomic_load(p, __ATOMIC_RELAXED, __HIP_MEMORY_SCOPE_AGENT); }
__device__ __forceinline__ unsigned xb_add(unsigned* p, unsigned v) { return __hip_atomic_fetch_add(p, v, __ATOMIC_RELAXED, __HIP_MEMORY_SCOPE_AGENT); }
__device__ __forceinline__ unsigned xb_xcc_id() { return (unsigned)__builtin_amdgcn_s_getreg((3 << 11) | 20) & 0xFu; }
#define XB_SPIN(cond, bar) do { unsigned _sp = 0; while (cond) { __builtin_amdgcn_s_sleep(1); \
    if ((++_sp & 255u) == 0u) { if (xb_ld(&(bar)[XB_TMO])) break; if (_sp > XB_SPIN_CAP) { atomicAdd(&(bar)[XB_TMO], 1u); break; } } } } while (0)

struct XcdBarrier {
    unsigned* bar; unsigned x;
    volatile LAS unsigned* st;
};

__device__ __forceinline__ XcdBarrier xcd_barrier_post(unsigned* bar, volatile LAS unsigned* st) {
    XcdBarrier b; b.bar = bar; b.x = xb_xcc_id(); b.st = st;
    if (threadIdx.x == 0) (void)xb_add(&bar[XB_XCNT(b.x)], 1u);
    return b;
}
__device__ __forceinline__ void xcd_barrier_complete(unsigned* bar, unsigned x, unsigned& nloc, unsigned& nx) {
    const unsigned G = gridDim.x * gridDim.y * gridDim.z;
    unsigned sum, cnt, mine, sp = 0u;
    for (;;) {
        sum = 0u; cnt = 0u; mine = 0u;
#pragma unroll
        for (unsigned j = 0; j < 16; ++j) { const unsigned c = xb_ld(&bar[XB_XCNT(j)]); sum += c; cnt += (c > 0u) ? 1u : 0u; mine = (j == x) ? c : mine; }
        if (sum == G) break;
        __builtin_amdgcn_s_sleep(1);
        if ((++sp & 255u) == 0u) { if (xb_ld(&bar[XB_TMO])) break; if (sp > XB_SPIN_CAP) { atomicAdd(&bar[XB_TMO], 1u); break; } }
    }
    nloc = mine > 0u ? mine : 1u; nx = cnt > 0u ? cnt : 1u;
}

__device__ __forceinline__ void xcd_barrier(const XcdBarrier& b) {
    asm volatile("s_waitcnt vmcnt(0)" ::: "memory");
    __syncthreads();
    if (threadIdx.x == 0) {
        unsigned* bar = b.bar;
        __builtin_amdgcn_s_waitcnt(0);
        unsigned nloc = b.st[0], nx = b.st[1];
        if (nloc == 0u) { xcd_barrier_complete(bar, b.x, nloc, nx); b.st[0] = nloc; b.st[1] = nx; }
        const unsigned old = xb_add(&bar[XB_XSUB(b.x)], 1u);
        const unsigned gen = old / nloc;
        if (old + 1u == (gen + 1u) * nloc) {
            __builtin_amdgcn_fence(__ATOMIC_RELEASE, "agent");
            asm volatile("s_waitcnt vmcnt(0)" ::: "memory");
            const unsigned og = xb_add(&bar[XB_TOP], 1u);
            const unsigned tg = og / nx;
            if (og + 1u == (tg + 1u) * nx) xb_add(&bar[XB_TOPGEN], 1u);
            else XB_SPIN(xb_ld(&bar[XB_TOPGEN]) == tg, bar);
            __builtin_amdgcn_fence(__ATOMIC_ACQUIRE, "agent");
            xb_add(&bar[XB_XGEN(b.x)], 1u);
            asm volatile("s_waitcnt vmcnt(0)" ::: "memory");
        } else {
            XB_SPIN(xb_ld(&bar[XB_XGEN(b.x)]) == gen, bar);
            __builtin_amdgcn_fence(__ATOMIC_ACQUIRE, "agent");
            asm volatile("s_waitcnt vmcnt(0)" ::: "memory");
        }
    }
    __syncthreads();
}

struct Args {
    const float* x; const float* attn_g; const float* w_in; const float* w_gate_up; const float* b_gate_up; const float* sb_g; const float* gla_g; const float* w_out;
    const float* ffn_g; const float* w_up; const float* conv_w; const float* conv_b; const float* w_down; const float* final_g;
    float* out; unsigned char* ws; int ph_lo, ph_hi, coop, pad;
};

DI void tr_item(const float* src, int ldsrc, const float* gain, float cscale, bf16_t* dst, int lddst, LAS float* scr, int lane) {
#pragma unroll 8
    for (int i = 0; i < 32; ++i) { const int kk = 2 * i + (lane >> 5); float v = src[(size_t)kk * ldsrc + (lane & 31)] * cscale; if (gain) v *= gain[kk]; scr[kk * 33 + (lane & 31)] = v; }
    asm volatile("s_waitcnt lgkmcnt(0)" ::: "memory");
    const int c = lane & 7;
#pragma unroll
    for (int j = 0; j < 4; ++j) { const int n = (lane >> 3) + 8 * j; const LAS float* s = scr + (8 * c) * 33 + n;
        u32x4 o; o.x = cvt_pk_bf16(s[0 * 33], s[1 * 33]); o.y = cvt_pk_bf16(s[2 * 33], s[3 * 33]); o.z = cvt_pk_bf16(s[4 * 33], s[5 * 33]); o.w = cvt_pk_bf16(s[6 * 33], s[7 * 33]);
        *(u32x4*)(dst + (size_t)n * lddst + 8 * c) = o; }
    asm volatile("s_waitcnt lgkmcnt(0)" ::: "memory");
}
DI void phase_prep(const Args& a, LAS unsigned char* lds) {
    const int tid = threadIdx.x, lane = tid & 63, wave = tid >> 6;
    const int gw = blockIdx.x * 8 + wave, NGW = gridDim.x * 8;
    LAS float* scr = (LAS float*)(lds + wave * 16384);
    bf16_t* Win = (bf16_t*)(a.ws + WS_WIN); bf16_t* Wout = (bf16_t*)(a.ws + WS_WOUT); bf16_t* Wup = (bf16_t*)(a.ws + WS_WUP); bf16_t* Wdn = (bf16_t*)(a.ws + WS_WDN);
    constexpr int I_IN = 16 * 96, I_OUT = 16 * 32, I_UP = 16 * 176, I_DN = 44 * 32, NIT = I_IN + I_OUT + I_UP + I_DN;
    for (int it = gw; it < NIT; it += NGW) {
        int r = it;
        if (r < I_IN) { const int kb = r / 96, nb = r % 96, k0 = 64 * kb, n0 = 32 * nb, c0 = n0 < 2560 ? n0 : n0 + 16;
            tr_item(a.w_in + (size_t)k0 * 3088 + c0, 3088, a.attn_g + k0, n0 < 512 ? QSCALE : 1.0f, Win + (size_t)n0 * D + k0, D, scr, lane); continue; }
        r -= I_IN;
        if (r < I_OUT) { const int kb = r / 32, nb = r % 32, k0 = 64 * kb, n0 = 32 * nb;
            tr_item(a.w_out + (size_t)k0 * D + n0, D, nullptr, 1.0f, Wout + (size_t)n0 * D + k0, D, scr, lane); continue; }
        r -= I_OUT;
        if (r < I_UP) { const int kb = r / 176, nb = r % 176, k0 = 64 * kb, n0 = 32 * nb, j = n0 >> 8, w = n0 & 255, c0 = w < 128 ? 128 * j + w : DFF + 128 * j + (w - 128);
            tr_item(a.w_up + (size_t)k0 * NU + c0, NU, a.ffn_g + k0, 1.0f, Wup + (size_t)n0 * D + k0, D, scr, lane); continue; }
        r -= I_UP;
        { const int kb = r / 32, nb = r % 32, k0 = 64 * kb, n0 = 32 * nb;
            tr_item(a.w_down + (size_t)k0 * D + n0, D, nullptr, 1.0f, Wdn + (size_t)n0 * DFF + k0, DFF, scr, lane); }
    }
    for (int it = blockIdx.x * 512 + tid; it < 256 * 128; it += gridDim.x * 512) {
        const int n = it >> 7, k0 = (it & 127) * 8;
        float wg[16];
#pragma unroll
        for (int r = 0; r < 16; ++r) wg[r] = a.w_gate_up[r * 256 + n];
        float o[8];
#pragma unroll
        for (int kk = 0; kk < 8; ++kk) { const float* wr_ = a.w_in + (size_t)(k0 + kk) * 3088 + 2560; float s = 0.f;
#pragma unroll
            for (int r4 = 0; r4 < 4; ++r4) { const f32x4 w4 = *(const f32x4*)(wr_ + 4 * r4); s += w4[0] * wg[4 * r4] + w4[1] * wg[4 * r4 + 1] + w4[2] * wg[4 * r4 + 2] + w4[3] * wg[4 * r4 + 3]; }
            o[kk] = s * a.attn_g[k0 + kk]; }
        u32x4 w; w.x = cvt_pk_bf16(o[0], o[1]); w.y = cvt_pk_bf16(o[2], o[3]); w.z = cvt_pk_bf16(o[4], o[5]); w.w = cvt_pk_bf16(o[6], o[7]);
        *(u32x4*)(Win + (size_t)(3072 + n) * D + k0) = w;
    }
    for (int it = gw; it < 256; it += NGW) {
        const int b = it >> 3, cgp = it & 7, col = (cgp < 4 ? 1536 + 64 * cgp : 1792 + 64 * (cgp - 4)) + lane;
        const float* xr = a.x + (size_t)b * SEQ * D; float s0 = 0.f, s1 = 0.f, s2 = 0.f, s3 = 0.f;
#pragma unroll 4
        for (int k = 0; k < D; k += 4) {
            s0 += xr[k] * a.attn_g[k] * a.w_in[(size_t)k * 3088 + col];
            s1 += xr[k + 1] * a.attn_g[k + 1] * a.w_in[(size_t)(k + 1) * 3088 + col];
            s2 += xr[k + 2] * a.attn_g[k + 2] * a.w_in[(size_t)(k + 2) * 3088 + col];
            s3 += xr[k + 3] * a.attn_g[k + 3] * a.w_in[(size_t)(k + 3) * 3088 + col];
        }
        ((float*)(a.ws + WS_QK0))[b * 512 + cgp * 64 + lane] = (s0 + s1) + (s2 + s3);
    }
    bf16_t* xb = (bf16_t*)(a.ws + WS_XB); float* rstd1 = (float*)(a.ws + WS_RSTD1);
    for (int m = gw; m < T; m += NGW) {
        const f32x4* xr = (const f32x4*)(a.x + (size_t)m * D) + lane; f32x4 v[4]; float s = 0.f;
#pragma unroll
        for (int j = 0; j < 4; ++j) { v[j] = xr[64 * j]; s += (v[j][0] * v[j][0] + v[j][1] * v[j][1]) + (v[j][2] * v[j][2] + v[j][3] * v[j][3]); }
        s = wave_sum(s);
        if (lane == 0) rstd1[m] = 1.0f / sqrtf(s * (1.0f / D) + EPS);
        u32x2* o8 = (u32x2*)(xb + (size_t)m * D) + lane;
#pragma unroll
        for (int j = 0; j < 4; ++j) { u32x2 w; w.x = cvt_pk_bf16(v[j][0], v[j][1]); w.y = cvt_pk_bf16(v[j][2], v[j][3]); o8[64 * j] = w; }
    }
}

#ifndef USE_TR
#define USE_TR 1
#endif
DI s16x4 gather4(const LAS unsigned char* base, int pitchB, int row0, int cbase, int lane) {
#if USE_TR
    const int i = lane & 15;
    const LAS unsigned char* p = base + (row0 + (i >> 2)) * pitchB + (cbase + 4 * (i & 3)) * 2;
    return __builtin_amdgcn_ds_read_tr16_b64_v4i16((LAS s16x4*)p);
#else
    const LAS unsigned char* p = base + row0 * pitchB + (cbase + (lane & 15)) * 2;
    s16x4 r;
    r[0] = *(const LAS short*)(p); r[1] = *(const LAS short*)(p + pitchB); r[2] = *(const LAS short*)(p + 2 * pitchB); r[3] = *(const LAS short*)(p + 3 * pitchB);
    return r;
#endif
}
DI bf16x8 cat8(s16x4 lo, s16x4 hi) { return __builtin_shufflevector(lo, hi, 0, 1, 2, 3, 4, 5, 6, 7); }
DI bf16x8 pack8(float a0, float a1, float a2, float a3, float a4, float a5, float a6, float a7) {
    u32x4 w; w.x = cvt_pk_bf16(a0, a1); w.y = cvt_pk_bf16(a2, a3); w.z = cvt_pk_bf16(a4, a5); w.w = cvt_pk_bf16(a6, a7); return __builtin_bit_cast(bf16x8, w);
}

constexpr float SB_CUT = 5.421010862427522e-20f;
constexpr int VPITCH = 144;
DI void sb_wave(const bf16_t* proj, bf16_t* ocat, const float* sbg, int b, int h, int q0, LAS unsigned char* vl, int lane) {
    const int r32 = lane & 31, h2 = lane >> 5;
    const size_t rowbase = (size_t)b * SEQ;
    bf16x8 qf[4];
    { const bf16_t* qp = proj + (rowbase + q0 + r32) * PP + Q_OFF + h * 64 + 8 * h2;
#pragma unroll
      for (int s = 0; s < 4; ++s) qf[s] = *(const bf16x8*)(qp + 16 * s); }
    f32x4 gsb[2][4];
#pragma unroll
    for (int dt = 0; dt < 2; ++dt)
#pragma unroll
        for (int gi = 0; gi < 4; ++gi) gsb[dt][gi] = *(const f32x4*)(sbg + h * 64 + 32 * dt + 8 * gi + 4 * h2);
    f32x16 o0, o1;
#pragma unroll
    for (int r = 0; r < 16; ++r) { o0[r] = 0.f; o1[r] = 0.f; }
    float carry = 1.f;
    const int grp = (lane >> 4) & 1;
    bf16x8 kn[4]; u32x4 vn0, vn1, vn2, vn3;
    { const int k0 = q0;
      const bf16_t* kp = proj + (rowbase + k0 + r32) * PP + K_OFF + h * 64 + 8 * h2;
#pragma unroll
      for (int s = 0; s < 4; ++s) kn[s] = *(const bf16x8*)(kp + 16 * s);
      const bf16_t* vp = proj + (rowbase + k0 + (lane >> 1)) * PP + V_OFF + h * 64 + 32 * (lane & 1);
      vn0 = *(const u32x4*)(vp); vn1 = *(const u32x4*)(vp + 8); vn2 = *(const u32x4*)(vp + 16); vn3 = *(const u32x4*)(vp + 24); }
    for (int kt = q0 >> 5; kt >= 0; --kt) {
        const int k0 = kt * 32; const bool diag = (k0 == q0);
        bf16x8 kf[4];
#pragma unroll
        for (int s = 0; s < 4; ++s) kf[s] = kn[s];
        { LAS unsigned char* dp = vl + (lane >> 1) * VPITCH + 64 * (lane & 1);
          *(LAS u32x4*)(dp) = vn0; *(LAS u32x4*)(dp + 16) = vn1; *(LAS u32x4*)(dp + 32) = vn2; *(LAS u32x4*)(dp + 48) = vn3; }
        if (kt > 0) {
            const int k1 = k0 - 32;
            const bf16_t* kp = proj + (rowbase + k1 + r32) * PP + K_OFF + h * 64 + 8 * h2;
#pragma unroll
            for (int s = 0; s < 4; ++s) kn[s] = *(const bf16x8*)(kp + 16 * s);
            const bf16_t* vp = proj + (rowbase + k1 + (lane >> 1)) * PP + V_OFF + h * 64 + 32 * (lane & 1);
            vn0 = *(const u32x4*)(vp); vn1 = *(const u32x4*)(vp + 8); vn2 = *(const u32x4*)(vp + 16); vn3 = *(const u32x4*)(vp + 24);
        }
        f32x16 z;
#pragma unroll
        for (int r = 0; r < 16; ++r) z[r] = 0.f;
#pragma unroll
        for (int s = 0; s < 4; ++s) z = __builtin_amdgcn_mfma_f32_32x32x16_bf16(kf[s], qf[s], z, 0, 0, 0);
        float om[16], be[16];
#pragma unroll
        for (int r = 0; r < 16; ++r) {
            const float e = fexp2(fminf(z[r], 80.f)); const float rc = __builtin_amdgcn_rcpf(1.f + e);
            float b_ = e * rc, o_ = rc;
            if (diag) { const int kvl = (r & 3) + 8 * (r >> 2) + 4 * h2; if (kvl >= r32) { b_ = 0.f; o_ = 1.f; } }
            be[r] = b_; om[r] = o_;
        }
        float sg[4], ps[4];
#pragma unroll
        for (int gi = 0; gi < 4; ++gi) { sg[gi] = (om[4 * gi] * om[4 * gi + 1]) * (om[4 * gi + 2] * om[4 * gi + 3]); ps[gi] = __shfl_xor(sg[gi], 32); }
        float e[4]; float run = 1.f;
#pragma unroll
        for (int gi = 3; gi >= 0; --gi) {
            const float hi = h2 ? sg[gi] : ps[gi], lo = h2 ? ps[gi] : sg[gi];
            const float e_hi = run; run *= hi; const float e_lo = run; run *= lo;
            e[gi] = h2 ? e_hi : e_lo;
        }
        float w[16];
#pragma unroll
        for (int gi = 0; gi < 4; ++gi) {
            float A = carry * e[gi];
#pragma unroll
            for (int j = 3; j >= 0; --j) { const int r = 4 * gi + j; w[r] = be[r] * A; A *= om[r]; }
        }
        carry *= run;
        asm volatile("s_waitcnt lgkmcnt(0)" ::: "memory");
#pragma unroll
        for (int s = 0; s < 2; ++s) {
            const bf16x8 pf = pack8(w[8 * s], w[8 * s + 1], w[8 * s + 2], w[8 * s + 3], w[8 * s + 4], w[8 * s + 5], w[8 * s + 6], w[8 * s + 7]);
            const bf16x8 va = cat8(gather4(vl, VPITCH, 16 * s + 4 * h2, 16 * grp, lane), gather4(vl, VPITCH, 16 * s + 8 + 4 * h2, 16 * grp, lane));
            const bf16x8 vb = cat8(gather4(vl, VPITCH, 16 * s + 4 * h2, 32 + 16 * grp, lane), gather4(vl, VPITCH, 16 * s + 8 + 4 * h2, 32 + 16 * grp, lane));
            o0 = __builtin_amdgcn_mfma_f32_32x32x16_bf16(va, pf, o0, 0, 0, 0);
            o1 = __builtin_amdgcn_mfma_f32_32x32x16_bf16(vb, pf, o1, 0, 0, 0);
        }
        asm volatile("s_waitcnt lgkmcnt(0)" ::: "memory");
        if (__all(carry < SB_CUT)) break;
    }
    float ss = 0.f;
#pragma unroll
    for (int r = 0; r < 16; ++r) ss += o0[r] * o0[r] + o1[r] * o1[r];
    ss += __shfl_xor(ss, 32);
    const float rs = 1.0f / sqrtf(ss * (1.0f / 64.0f) + EPS);
    bf16_t* op = ocat + (rowbase + q0 + r32) * D + h * 64;
#pragma unroll
    for (int dt = 0; dt < 2; ++dt)
#pragma unroll
        for (int gi = 0; gi < 4; ++gi) {
            const int d = 32 * dt + 8 * gi + 4 * h2; const f32x4 gg = gsb[dt][gi];
            const f32x16& o = dt ? o1 : o0;
            u32x2 wv; wv.x = cvt_pk_bf16(o[4 * gi] * rs * gg[0], o[4 * gi + 1] * rs * gg[1]); wv.y = cvt_pk_bf16(o[4 * gi + 2] * rs * gg[2], o[4 * gi + 3] * rs * gg[3]);
            *(u32x2*)(op + d) = wv;
        }
}

constexpr int GP = 144, GVP = 272;
constexpr int G_QD = 0, G_KI = 64 * GP, G_KE = 2 * 64 * GP, G_V = 3 * 64 * GP, G_DEC = G_V + 64 * GVP, G_SSQ = G_DEC + 256, G_END = G_SSQ + 8 * 64 * 4;
DI void gla_unit(const Args& a, int b, int h, LAS unsigned char* lds) {
    const int tid = threadIdx.x, lane = tid & 63, w = tid >> 6, c = lane & 15, g = lane >> 4;
    const bf16_t* proj = (const bf16_t*)(a.ws + WS_PROJ); const float* b2 = (const float*)(a.ws + WS_B2); bf16_t* ocat = (bf16_t*)(a.ws + WS_OCAT);
    const size_t rowbase = (size_t)b * SEQ;
    f32x4 S[4];
#pragma unroll
    for (int dt = 0; dt < 4; ++dt) S[dt] = (f32x4){0.f, 0.f, 0.f, 0.f};
    const int si = tid >> 3, sc8 = (tid & 7) * 8, sv16 = (tid & 7) * 16;
    const f32x4 gg = *(const f32x4*)(a.gla_g + h * 128 + 16 * w + 4 * g);
    float s00;
    {
        const float* qk0 = (const float*)(a.ws + WS_QK0) + b * 512;
        const float rs1 = ((const float*)(a.ws + WS_RSTD1))[rowbase];
        s00 = wave_sum(qk0[h * 64 + lane] * qk0[256 + h * 64 + lane]) * rs1 * rs1 * 0.125f;
    }
    u32x4 pqvA, pkvA, pv0A, pv1A, pqvB, pkvB, pv0B, pv1B; f32x4 pbaA, pbbA, pbaB, pbbB; u32x2 pogA[4], pogB[4];
#define GLA_LOAD(nn, X) do { const size_t t0_ = rowbase + 64 * (nn), row_ = t0_ + si; \
        pqv##X = *(const u32x4*)(proj + row_ * PP + GQ_OFF + h * 64 + sc8); pkv##X = *(const u32x4*)(proj + row_ * PP + GK_OFF + h * 64 + sc8); \
        pba##X = *(const f32x4*)(b2 + row_ * 256 + h * 64 + sc8); pbb##X = *(const f32x4*)(b2 + row_ * 256 + h * 64 + sc8 + 4); \
        pv0##X = *(const u32x4*)(proj + row_ * PP + GV_OFF + h * 128 + sv16); pv1##X = *(const u32x4*)(proj + row_ * PP + GV_OFF + h * 128 + sv16 + 8); \
        _Pragma("unroll") for (int it_ = 0; it_ < 4; ++it_) pog##X[it_] = *(const u32x2*)(proj + (t0_ + 16 * it_ + c) * PP + OG_OFF + h * 128 + 16 * w + 4 * g); } while (0)
    GLA_LOAD(0, A); GLA_LOAD(1, B);
    for (int n2 = 0; n2 < 32; n2 += 2) {
        { const int n = n2;
        const size_t t0 = rowbase + 64 * n;
        f32x4 sil[4];
        {
            const u32x4 qv = pqvA, kv = pkvA; const f32x4 ba = pbaA, bb = pbbA; const u32x4 v0 = pv0A, v1 = pv1A;
#pragma unroll
            for (int it = 0; it < 4; ++it) { const float og[4] = {bflo(pogA[it].x), bfhi(pogA[it].x), bflo(pogA[it].y), bfhi(pogA[it].y)};
#pragma unroll
                for (int r = 0; r < 4; ++r) sil[it][r] = og[r] * __builtin_amdgcn_rcpf(1.f + fexp2(-og[r] * LOG2E)) * gg[r]; }
            asm volatile("" : "+v"(sil[0]), "+v"(sil[1]), "+v"(sil[2]), "+v"(sil[3]));
            float qd[8], ki[8];
#pragma unroll
            for (int j = 0; j < 4; ++j) {
                const unsigned qw = qv[j], kw = kv[j];
                const float bl = (2 * j < 4) ? ba[2 * j] : bb[2 * j - 4], bh = (2 * j + 1 < 4) ? ba[2 * j + 1] : bb[2 * j + 1 - 4];
                qd[2 * j] = bflo(qw) * 0.125f * fexp2(bl); qd[2 * j + 1] = bfhi(qw) * 0.125f * fexp2(bh);
                ki[2 * j] = bflo(kw) * fexp2(-bl);         ki[2 * j + 1] = bfhi(kw) * fexp2(-bh);
            }
            *(LAS bf16x8*)(lds + G_QD + si * GP + sc8 * 2) = pack8(qd[0], qd[1], qd[2], qd[3], qd[4], qd[5], qd[6], qd[7]);
            *(LAS bf16x8*)(lds + G_KI + si * GP + sc8 * 2) = pack8(ki[0], ki[1], ki[2], ki[3], ki[4], ki[5], ki[6], ki[7]);
            *(LAS u32x4*)(lds + G_V + si * GVP + sv16 * 2) = v0; *(LAS u32x4*)(lds + G_V + si * GVP + sv16 * 2 + 16) = v1;
            if (si == 63) { LAS float* dp = (LAS float*)(lds + G_DEC) + sc8;
#pragma unroll
                for (int j = 0; j < 4; ++j) { dp[j] = fexp2(ba[j]); dp[4 + j] = fexp2(bb[j]); } }
        }
        if (n + 2 < 32) GLA_LOAD(n + 2, A);
        asm volatile("s_waitcnt lgkmcnt(0)" ::: "memory"); __builtin_amdgcn_s_barrier(); asm volatile("" ::: "memory");
        bf16x8 vT[2], Sb[2];
#pragma unroll
        for (int s = 0; s < 2; ++s) {
            vT[s] = cat8(gather4(lds + G_V, GVP, 32 * s + 4 * g, 16 * w, lane), gather4(lds + G_V, GVP, 32 * s + 16 + 4 * g, 16 * w, lane));
            Sb[s] = pack8(S[2 * s][0], S[2 * s][1], S[2 * s][2], S[2 * s][3], S[2 * s + 1][0], S[2 * s + 1][1], S[2 * s + 1][2], S[2 * s + 1][3]);
        }
        f32x4 o[4];
#pragma unroll
        for (int it = 0; it < 4; ++it) {
            asm volatile("" ::: "memory");
            const LAS unsigned char* qrow = lds + G_QD + (16 * it + c) * GP;
            const bf16x8 qn0 = *(const LAS bf16x8*)(qrow + 16 * g), qn1 = *(const LAS bf16x8*)(qrow + 64 + 16 * g);
            f32x4 P[4];
#pragma unroll
            for (int jt = 0; jt < 4; ++jt) {
                P[jt] = (f32x4){0.f, 0.f, 0.f, 0.f};
                if (jt <= it) {
                    const LAS unsigned char* krow = lds + G_KI + (16 * jt + c) * GP;
                    const bf16x8 k0 = *(const LAS bf16x8*)(krow + 16 * g), k1 = *(const LAS bf16x8*)(krow + 64 + 16 * g);
                    P[jt] = __builtin_amdgcn_mfma_f32_16x16x32_bf16(k0, qn0, P[jt], 0, 0, 0);
                    P[jt] = __builtin_amdgcn_mfma_f32_16x16x32_bf16(k1, qn1, P[jt], 0, 0, 0);
                    if (jt == it) {
#pragma unroll
                        for (int r = 0; r < 4; ++r) if (4 * g + r > c) P[jt][r] = 0.f;
                        if (it == 0 && n == 0 && lane == 0) P[jt][0] = s00;
                    }
                }
            }
            f32x4 acc = {0.f, 0.f, 0.f, 0.f};
            { const bf16x8 pb = pack8(P[0][0], P[0][1], P[0][2], P[0][3], P[1][0], P[1][1], P[1][2], P[1][3]);
              acc = __builtin_amdgcn_mfma_f32_16x16x32_bf16(vT[0], pb, acc, 0, 0, 0); }
            if (it >= 2) { const bf16x8 pb = pack8(P[2][0], P[2][1], P[2][2], P[2][3], P[3][0], P[3][1], P[3][2], P[3][3]);
              acc = __builtin_amdgcn_mfma_f32_16x16x32_bf16(vT[1], pb, acc, 0, 0, 0); }
#pragma unroll
            for (int s = 0; s < 2; ++s) {
                const s16x4 qa = *(const LAS s16x4*)(qrow + (32 * s + 4 * g) * 2), qb = *(const LAS s16x4*)(qrow + (32 * s + 16 + 4 * g) * 2);
                acc = __builtin_amdgcn_mfma_f32_16x16x32_bf16(Sb[s], cat8(qa, qb), acc, 0, 0, 0);
            }
            o[it] = acc;
        }
#pragma unroll
        for (int dt = 0; dt < 4; ++dt) {
            const f32x4 dec = *(const LAS f32x4*)(lds + G_DEC + (16 * dt + 4 * g) * 4);
            f32x4 sacc = S[dt];
#pragma unroll
            for (int s = 0; s < 2; ++s) {
                const bf16x8 ka = cat8(gather4(lds + G_KI, GP, 32 * s + 4 * g, 16 * dt, lane), gather4(lds + G_KI, GP, 32 * s + 16 + 4 * g, 16 * dt, lane));
                sacc = __builtin_amdgcn_mfma_f32_16x16x32_bf16(ka, vT[s], sacc, 0, 0, 0);
            }
            S[dt] = sacc * dec;
        }
#pragma unroll
        for (int it = 0; it < 4; ++it) {
            float s = (o[it][0] * o[it][0] + o[it][1] * o[it][1]) + (o[it][2] * o[it][2] + o[it][3] * o[it][3]);
            s += __shfl_xor(s, 16); s += __shfl_xor(s, 32);
            if (g == 0) ((LAS float*)(lds + G_SSQ))[w * 64 + 16 * it + c] = s;
        }
        asm volatile("s_waitcnt lgkmcnt(0)" ::: "memory"); __builtin_amdgcn_s_barrier(); asm volatile("" ::: "memory");
#pragma unroll
        for (int it = 0; it < 4; ++it) {
            const int i = 16 * it + c; float tot = 0.f;
#pragma unroll
            for (int ww = 0; ww < 8; ++ww) tot += ((const LAS float*)(lds + G_SSQ))[ww * 64 + i];
            const float rs = 1.0f / sqrtf(tot * (1.0f / 128.0f) + EPS);
            const size_t row = t0 + i;
            float ov[4];
#pragma unroll
            for (int r = 0; r < 4; ++r) ov[r] = o[it][r] * rs * sil[it][r];
            u32x2 wv; wv.x = cvt_pk_bf16(ov[0], ov[1]); wv.y = cvt_pk_bf16(ov[2], ov[3]);
            *(u32x2*)(ocat + row * D + 512 + h * 128 + 16 * w + 4 * g) = wv;
        }
        }
        { const int n = n2 + 1;
        const size_t t0 = rowbase + 64 * n;
        f32x4 sil[4];
        {
            const u32x4 qv = pqvB, kv = pkvB; const f32x4 ba = pbaB, bb = pbbB; const u32x4 v0 = pv0B, v1 = pv1B;
#pragma unroll
            for (int it = 0; it < 4; ++it) { const float og[4] = {bflo(pogB[it].x), bfhi(pogB[it].x), bflo(pogB[it].y), bfhi(pogB[it].y)};
#pragma unroll
                for (int r = 0; r < 4; ++r) sil[it][r] = og[r] * __builtin_amdgcn_rcpf(1.f + fexp2(-og[r] * LOG2E)) * gg[r]; }
            asm volatile("" : "+v"(sil[0]), "+v"(sil[1]), "+v"(sil[2]), "+v"(sil[3]));
            float qd[8], ki[8];
#pragma unroll
            for (int j = 0; j < 4; ++j) {
                const unsigned qw = qv[j], kw = kv[j];
                const float bl = (2 * j < 4) ? ba[2 * j] : bb[2 * j - 4], bh = (2 * j + 1 < 4) ? ba[2 * j + 1] : bb[2 * j + 1 - 4];
                qd[2 * j] = bflo(qw) * 0.125f * fexp2(bl); qd[2 * j + 1] = bfhi(qw) * 0.125f * fexp2(bh);
                ki[2 * j] = bflo(kw) * fexp2(-bl);         ki[2 * j + 1] = bfhi(kw) * fexp2(-bh);
            }
            *(LAS bf16x8*)(lds + G_QD + si * GP + sc8 * 2) = pack8(qd[0], qd[1], qd[2], qd[3], qd[4], qd[5], qd[6], qd[7]);
            *(LAS bf16x8*)(lds + G_KI + si * GP + sc8 * 2) = pack8(ki[0], ki[1], ki[2], ki[3], ki[4], ki[5], ki[6], ki[7]);
            *(LAS u32x4*)(lds + G_V + si * GVP + sv16 * 2) = v0; *(LAS u32x4*)(lds + G_V + si * GVP + sv16 * 2 + 16) = v1;
            if (si == 63) { LAS float* dp = (LAS float*)(lds + G_DEC) + sc8;
#pragma unroll
                for (int j = 0; j < 4; ++j) { dp[j] = fexp2(ba[j]); dp[4 + j] = fexp2(bb[j]); } }
        }
        if (n + 2 < 32) GLA_LOAD(n + 2, B);
        asm volatile("s_waitcnt lgkmcnt(0)" ::: "memory"); __builtin_amdgcn_s_barrier(); asm volatile("" ::: "memory");
        bf16x8 vT[2], Sb[2];
#pragma unroll
        for (int s = 0; s < 2; ++s) {
            vT[s] = cat8(gather4(lds + G_V, GVP, 32 * s + 4 * g, 16 * w, lane), gather4(lds + G_V, GVP, 32 * s + 16 + 4 * g, 16 * w, lane));
            Sb[s] = pack8(S[2 * s][0], S[2 * s][1], S[2 * s][2], S[2 * s][3], S[2 * s + 1][0], S[2 * s + 1][1], S[2 * s + 1][2], S[2 * s + 1][3]);
        }
        f32x4 o[4];
#pragma unroll
        for (int it = 0; it < 4; ++it) {
            asm volatile("" ::: "memory");
            const LAS unsigned char* qrow = lds + G_QD + (16 * it + c) * GP;
            const bf16x8 qn0 = *(const LAS bf16x8*)(qrow + 16 * g), qn1 = *(const LAS bf16x8*)(qrow + 64 + 16 * g);
            f32x4 P[4];
#pragma unroll
            for (int jt = 0; jt < 4; ++jt) {
                P[jt] = (f32x4){0.f, 0.f, 0.f, 0.f};
                if (jt <= it) {
                    const LAS unsigned char* krow = lds + G_KI + (16 * jt + c) * GP;
                    const bf16x8 k0 = *(const LAS bf16x8*)(krow + 16 * g), k1 = *(const LAS bf16x8*)(krow + 64 + 16 * g);
                    P[jt] = __builtin_amdgcn_mfma_f32_16x16x32_bf16(k0, qn0, P[jt], 0, 0, 0);
                    P[jt] = __builtin_amdgcn_mfma_f32_16x16x32_bf16(k1, qn1, P[jt], 0, 0, 0);
                    if (jt == it) {
#pragma unroll
                        for (int r = 0; r < 4; ++r) if (4 * g + r > c) P[jt][r] = 0.f;
                        if (it == 0 && n == 0 && lane == 0) P[jt][0] = s00;
                    }
                }
            }
            f32x4 acc = {0.f, 0.f, 0.f, 0.f};
            { const bf16x8 pb = pack8(P[0][0], P[0][1], P[0][2], P[0][3], P[1][0], P[1][1], P[1][2], P[1][3]);
              acc = __builtin_amdgcn_mfma_f32_16x16x32_bf16(vT[0], pb, acc, 0, 0, 0); }
            if (it >= 2) { const bf16x8 pb = pack8(P[2][0], P[2][1], P[2][2], P[2][3], P[3][0], P[3][1], P[3][2], P[3][3]);
              acc = __builtin_amdgcn_mfma_f32_16x16x32_bf16(vT[1], pb, acc, 0, 0, 0); }
#pragma unroll
            for (int s = 0; s < 2; ++s) {
                const s16x4 qa = *(const LAS s16x4*)(qrow + (32 * s + 4 * g) * 2), qb = *(const LAS s16x4*)(qrow + (32 * s + 16 + 4 * g) * 2);
                acc = __builtin_amdgcn_mfma_f32_16x16x32_bf16(Sb[s], cat8(qa, qb), acc, 0, 0, 0);
            }
            o[it] = acc;
        }
#pragma unroll
        for (int dt = 0; dt < 4; ++dt) {
            const f32x4 dec = *(const LAS f32x4*)(lds + G_DEC + (16 * dt + 4 * g) * 4);
            f32x4 sacc = S[dt];
#pragma unroll
            for (int s = 0; s < 2; ++s) {
                const bf16x8 ka = cat8(gather4(lds + G_KI, GP, 32 * s + 4 * g, 16 * dt, lane), gather4(lds + G_KI, GP, 32 * s + 16 + 4 * g, 16 * dt, lane));
                sacc = __builtin_amdgcn_mfma_f32_16x16x32_bf16(ka, vT[s], sacc, 0, 0, 0);
            }
            S[dt] = sacc * dec;
        }
#pragma unroll
        for (int it = 0; it < 4; ++it) {
            float s = (o[it][0] * o[it][0] + o[it][1] * o[it][1]) + (o[it][2] * o[it][2] + o[it][3] * o[it][3]);
            s += __shfl_xor(s, 16); s += __shfl_xor(s, 32);
            if (g == 0) ((LAS float*)(lds + G_SSQ))[w * 64 + 16 * it + c] = s;
        }
        asm volatile("s_waitcnt lgkmcnt(0)" ::: "memory"); __builtin_amdgcn_s_barrier(); asm volatile("" ::: "memory");
#pragma unroll
        for (int it = 0; it < 4; ++it) {
            const int i = 16 * it + c; float tot = 0.f;
#pragma unroll
            for (int ww = 0; ww < 8; ++ww) tot += ((const LAS float*)(lds + G_SSQ))[ww * 64 + i];
            const float rs = 1.0f / sqrtf(tot * (1.0f / 128.0f) + EPS);
            const size_t row = t0 + i;
            float ov[4];
#pragma unroll
            for (int r = 0; r < 4; ++r) ov[r] = o[it][r] * rs * sil[it][r];
            u32x2 wv; wv.x = cvt_pk_bf16(ov[0], ov[1]); wv.y = cvt_pk_bf16(ov[2], ov[3]);
            *(u32x2*)(ocat + row * D + 512 + h * 128 + 16 * w + 4 * g) = wv;
        }
        }
    }
    __syncthreads();
}

DI void phase_mix(const Args& a, LAS unsigned char* lds, int cidx = 0, int mode = 0) {
    const int tid = threadIdx.x, lane = tid & 63, w = tid >> 6;
    unsigned* ctr = (unsigned*)(a.ws + WS_CTL) + 64 * cidx;
    volatile LAS unsigned* sh = (volatile LAS unsigned*)(lds + MISC_OFF);
    constexpr int NGLA = NB * 4, NSB = NB * 8 * 8, NUNIT = NGLA + NSB;
    unsigned nxt = 0;
    if (tid == 0) nxt = atomicAdd(ctr, 1u);
    for (;;) {
        if (tid == 0) sh[0] = nxt;
        __syncthreads();
        const int u = (int)sh[0];
        __syncthreads();
        if (u >= NUNIT) break;
        if (tid == 0) nxt = atomicAdd(ctr, 1u);
        if (u < NGLA) { if (mode != 1) gla_unit(a, u >> 2, u & 3, lds); }
        else if (mode != 2) {
            const int v = u - NGLA, bh = v >> 3, qb = 7 - (v & 7);
            sb_wave((const bf16_t*)(a.ws + WS_PROJ), (bf16_t*)(a.ws + WS_OCAT), a.sb_g, bh >> 3, bh & 7, qb * 256 + 32 * w, lds + w * 8192, lane);
        }
    }
}

DI void phase_fix(const Args& a) {
    const float* hh = (const float*)(a.ws + WS_HHEAD); const float* ht = (const float*)(a.ws + WS_HTAIL); bf16_t* g = (bf16_t*)(a.ws + WS_G);
    constexpr int PER = 2 * 704;
    for (int it = blockIdx.x * 512 + threadIdx.x; it < 256 * PER; it += gridDim.x * 512) {
        const int pm = it / PER, rem = it % PER, rr = rem / 704, ch = (rem % 704) * 4;
        if ((pm & 7) == 0) continue;
        const int j = ch >> 7, wv = ch & 127, pa = 256 * j + wv, pv = pa + 128;
        const float* t0 = ht + ((size_t)(pm - 1) * 2) * NU; const float* t1 = t0 + NU; const float* h0 = hh + ((size_t)pm * 2) * NU; const float* h1 = h0 + NU;
        const float *m2 = rr == 0 ? t0 : t1, *m1 = rr == 0 ? t1 : h0, *m0 = rr == 0 ? h0 : h1;
        const f32x4 a2 = *(const f32x4*)(m2 + pa), a1 = *(const f32x4*)(m1 + pa), a0 = *(const f32x4*)(m0 + pa);
        const f32x4 v2 = *(const f32x4*)(m2 + pv), v1 = *(const f32x4*)(m1 + pv), v0 = *(const f32x4*)(m0 + pv);
        const f32x4 wa0 = *(const f32x4*)(a.conv_w + ch), wa1 = *(const f32x4*)(a.conv_w + NU + ch), wa2 = *(const f32x4*)(a.conv_w + 2 * NU + ch), ba = *(const f32x4*)(a.conv_b + ch);
        const f32x4 wv0 = *(const f32x4*)(a.conv_w + DFF + ch), wv1 = *(const f32x4*)(a.conv_w + NU + DFF + ch), wv2 = *(const f32x4*)(a.conv_w + 2 * NU + DFF + ch), bv = *(const f32x4*)(a.conv_b + DFF + ch);
        const f32x4 av = ba + wa0 * a2 + wa1 * a1 + wa2 * a0, vv = bv + wv0 * v2 + wv1 * v1 + wv2 * v0;
        float o[4];
#pragma unroll
        for (int c = 0; c < 4; ++c) o[c] = av[c] * vv[c] * __builtin_amdgcn_rcpf(1.f + fexp2(-av[c] * LOG2E));
        u32x2 w; w.x = cvt_pk_bf16(o[0], o[1]); w.y = cvt_pk_bf16(o[2], o[3]);
        *(u32x2*)(g + (size_t)(pm * 256 + rr) * DFF + ch) = w;
    }
}

DI void phase_final(const Args& a) {
    const int lane = threadIdx.x & 63, gw = blockIdx.x * 8 + (threadIdx.x >> 6), NGW = gridDim.x * 8;
    const float* ssq3 = (const float*)(a.ws + WS_SSQ3);
    f32x4 gv[4];
#pragma unroll
    for (int j = 0; j < 4; ++j) gv[j] = ((const f32x4*)a.final_g)[lane + 64 * j];
    for (int m = gw; m < T; m += NGW) {
        const float rs = 1.0f / sqrtf(ssq3[m] * (1.0f / D) + EPS);
        f32x4* xr = (f32x4*)(a.out + (size_t)m * D) + lane;
#pragma unroll
        for (int j = 0; j < 4; ++j) { const f32x4 v = xr[64 * j]; xr[64 * j] = v * rs * gv[j]; }
    }
}

__global__ void __launch_bounds__(512, 2) fwd(Args a) {
    extern __shared__ __attribute__((aligned(16))) unsigned char smem[];
    LAS unsigned char* lds = (LAS unsigned char*)smem;
    const int lo = a.ph_lo, hi = a.ph_hi;
    const int G = gridDim.x, cu = blockIdx.x;
#ifndef PH_MASK
#define PH_MASK 255
#endif
#define IN(k) (((PH_MASK >> (k)) & 1) && lo <= (k) && (k) < hi)
    volatile LAS unsigned* MISC = (volatile LAS unsigned*)(lds + MISC_OFF);
    if (threadIdx.x < 16) MISC[threadIdx.x] = 0u;
    __syncthreads();
    XcdBarrier xbar; xbar.bar = (unsigned*)(a.ws + WS_CTL) + 24576; xbar.x = 0; xbar.st = nullptr;
    if (a.coop) xbar = xcd_barrier_post((unsigned*)(a.ws + WS_CTL) + 24576, MISC + 8);
    if (a.pad == 0x7eadbeef) cg::this_grid().sync();
#define SEAM(k) do { if (a.coop && IN(k) && IN((k) + 1)) { xcd_barrier(xbar); } } while (0)
    if (IN(0)) { phase_prep(a, lds);
#ifdef PROBE_P0
        cg::this_grid().sync(); phase_prep(a, lds);
#endif
#ifdef PROBE_SYNC4
#endif
    }
    SEAM(0);
#ifdef PROBE_SYNC4
    xcd_barrier(xbar); xcd_barrier(xbar); xcd_barrier(xbar); xcd_barrier(xbar);
#endif
    if (IN(1)) {
        pg8::Gemm g{(const bf16_t*)(a.ws + WS_XB), (const bf16_t*)(a.ws + WS_WIN), T, N1, D}; pg8::StaticOrder S; S.init(T, N1, G, cu);
        Epi1 E{(bf16_t*)(a.ws + WS_PROJ), (float*)(a.ws + WS_B2), (const float*)(a.ws + WS_RSTD1), a.b_gate_up};
        pg8::gemm_phase<Epi1, pg8::StaticOrder>(lds, g, S, E);
#ifdef PROBE_G1
        cg::this_grid().sync(); pg8::gemm_phase<Epi1, pg8::StaticOrder>(lds, g, S, E);
#endif
    }
    SEAM(1);
    if (IN(2)) { phase_mix(a, lds);
#ifdef PROBE_MIX2
        cg::this_grid().sync(); phase_mix(a, lds, 1, PROBE_MIX2);
#endif
    }
    SEAM(2);
    if (IN(3)) {
        pg8::Gemm g{(const bf16_t*)(a.ws + WS_OCAT), (const bf16_t*)(a.ws + WS_WOUT), T, D, D}; pg8::StaticOrder S; S.init(T, D, G, cu);
        EpiRes<true> E{a.x, a.out, (bf16_t*)(a.ws + WS_XB), (float*)(a.ws + WS_SSQ2)};
        pg8::gemm_phase<EpiRes<true>, pg8::StaticOrder>(lds, g, S, E);
    }
    SEAM(3);
    if (IN(4)) {
        pg8::Gemm g{(const bf16_t*)(a.ws + WS_XB), (const bf16_t*)(a.ws + WS_WUP), T, NU, D}; pg8::StaticOrder S; S.init(T, NU, G, cu);
        Epi3 E{(bf16_t*)(a.ws + WS_G), (const float*)(a.ws + WS_SSQ2), a.conv_w, a.conv_b, (float*)(a.ws + WS_HHEAD), (float*)(a.ws + WS_HTAIL), (LAS float*)(lds + HALO_OFF)};
        pg8::gemm_phase<Epi3, pg8::StaticOrder>(lds, g, S, E);
#ifdef PROBE_G3
        cg::this_grid().sync(); pg8::gemm_phase<Epi3, pg8::StaticOrder>(lds, g, S, E);
#endif
    }
    SEAM(4);
    if (IN(5)) { phase_fix(a); }
    SEAM(5);
    const bool fused_final = (G == 256) && a.coop;
    if (IN(6)) {
        pg8::Gemm g{(const bf16_t*)(a.ws + WS_G), (const bf16_t*)(a.ws + WS_WDN), T, D, DFF}; pg8::StaticOrder S; S.init(T, D, G, cu);
        if (fused_final) {
            Epi4F E{a.out, a.out, a.final_g, (float*)(a.ws + WS_XCH), (unsigned*)(a.ws + WS_CTL) + 4096, (LAS float*)(lds + HALO_OFF)};
            pg8::gemm_phase<Epi4F, pg8::StaticOrder>(lds, g, S, E);
        } else {
            EpiRes<false> E{a.out, a.out, nullptr, (float*)(a.ws + WS_SSQ3)};
            pg8::gemm_phase<EpiRes<false>, pg8::StaticOrder>(lds, g, S, E);
        }
    }
    if (!fused_final) {
        SEAM(6);
        if (IN(7)) { phase_final(a); }
    }
#undef IN
#undef SEAM
}

#ifndef ONE_LAUNCH
#define ONE_LAUNCH 1
#endif
extern "C" void kernel_launch(void* const* d_in, const int* in_sizes, int n_in, void* d_out, int out_size, void* d_ws, size_t ws_size, hipStream_t stream) {
    static int grid = 0;
    if (grid == 0) {
        if (n_in != 14 || ws_size < WS_END) { fprintf(stderr, "kernel_launch: unexpected inputs (n_in %d, ws %zu)\n", n_in, ws_size); grid = -1; return; }
        int dev = 0, cus = 0, per_cu = 0;
        hipGetDevice(&dev); hipDeviceGetAttribute(&cus, hipDeviceAttributeMultiprocessorCount, dev);
        if (hipFuncSetAttribute((const void*)fwd, hipFuncAttributeMaxDynamicSharedMemorySize, LDS_BYTES) != hipSuccess) { fprintf(stderr, "kernel_launch: hipFuncSetAttribute failed\n"); grid = -1; return; }
        hipOccupancyMaxActiveBlocksPerMultiprocessor(&per_cu, (const void*)fwd, 512, LDS_BYTES);
        (void)hipGetLastError();
        if (per_cu < 1) per_cu = 1;
        grid = cus * per_cu;
        if (grid != 256) fprintf(stderr, "kernel_launch: note: grid %d (cus %d x %d)\n", grid, cus, per_cu);
    }
    if (grid < 0) return;
    hipMemsetAsync((char*)d_ws + WS_CTL, 0, 768 * 1024, stream);
    Args a{};
    a.x = (const float*)d_in[0]; a.attn_g = (const float*)d_in[1]; a.w_in = (const float*)d_in[2]; a.w_gate_up = (const float*)d_in[3]; a.b_gate_up = (const float*)d_in[4];
    a.sb_g = (const float*)d_in[5]; a.gla_g = (const float*)d_in[6]; a.w_out = (const float*)d_in[7]; a.ffn_g = (const float*)d_in[8]; a.w_up = (const float*)d_in[9];
    a.conv_w = (const float*)d_in[10]; a.conv_b = (const float*)d_in[11]; a.w_down = (const float*)d_in[12]; a.final_g = (const float*)d_in[13];
    a.out = (float*)d_out; a.ws = (unsigned char*)d_ws;
#if ONE_LAUNCH
    a.ph_lo = 0; a.ph_hi = 8; a.coop = 1;
    void* args[] = {&a};
    hipError_t e = hipLaunchCooperativeKernel((const void*)fwd, dim3(grid), dim3(512), args, LDS_BYTES, stream);
    if (e != hipSuccess) fprintf(stderr, "cooperative launch failed: %s (grid %d)\n", hipGetErrorString(e), grid);
#else
    for (int p = 0; p < 8; ++p) { a.ph_lo = p; a.ph_hi = p + 1; a.coop = 0; hipLaunchKernelGGL(fwd, dim3(grid), dim3(512), LDS_BYTES, stream, a); }
#endif
}
```

```cpp
#include <hip/hip_runtime.h>
#include <hip/hip_cooperative_groups.h>
#include <cstdio>
#include <cstdint>
namespace cg = cooperative_groups;

#define DI __device__ __forceinline__
#define LAS __attribute__((address_space(3)))
typedef unsigned short bf16_t;
typedef short bf16x8 __attribute__((ext_vector_type(8)));
typedef short s16x4 __attribute__((ext_vector_type(4)));
typedef float f32x4 __attribute__((ext_vector_type(4)));
typedef float f32x2 __attribute__((ext_vector_type(2)));
typedef float f32x16 __attribute__((ext_vector_type(16)));
typedef unsigned u32x4 __attribute__((ext_vector_type(4)));
typedef unsigned u32x2 __attribute__((ext_vector_type(2)));
typedef __bf16 bf16x2_t __attribute__((ext_vector_type(2)));

constexpr int T = 65536, SEQ = 2048, NB = 32, D = 1024;
constexpr int PP = 3072;
constexpr int Q_OFF = 0, K_OFF = 512, V_OFF = 1024, GQ_OFF = 1536, GK_OFF = 1792, GV_OFF = 2048, OG_OFF = 2560;
constexpr int N1 = 3328;
constexpr int DFF = 2816, NU = 5632;
constexpr float EPS = 1e-6f;
constexpr float LOG2E = 1.4426950408889634f;
constexpr float QSCALE = 0.125f * LOG2E;

constexpr size_t MiB = 1u << 20;
constexpr size_t WS_CTL = 0;
constexpr size_t WS_SSQ2 = 256 * 1024, WS_SSQ3 = 512 * 1024, WS_RSTD1 = 768 * 1024;
constexpr size_t WS_QK0 = 1 * MiB;
constexpr size_t WS_WIN = 2 * MiB, WS_WOUT = 9 * MiB, WS_WUP = 11 * MiB, WS_WDN = 22 * MiB;
constexpr size_t WS_HHEAD = 28 * MiB, WS_HTAIL = 39 * MiB;
constexpr size_t WS_XCH = 50 * MiB;
constexpr size_t WS_XB = 64 * MiB;
constexpr size_t WS_PROJ = 192 * MiB;
constexpr size_t WS_B2 = 576 * MiB;
constexpr size_t WS_OCAT = 640 * MiB;
constexpr size_t WS_G = 192 * MiB;
constexpr size_t WS_END = 768 * MiB;

constexpr int GEMM_LDS = 131072;
constexpr int HALO_OFF = GEMM_LDS;
constexpr int MISC_OFF = HALO_OFF + 10240;
constexpr int PF_OFF = MISC_OFF + 64;
constexpr int LDS_BYTES = 152576;

DI unsigned cvt_pk_bf16(float lo, float hi) { f32x2 v = {lo, hi}; bf16x2_t b = __builtin_convertvector(v, bf16x2_t); return __builtin_bit_cast(unsigned, b); }
DI float bf2f(unsigned short v) { return __uint_as_float(((unsigned)v) << 16); }
DI float bflo(unsigned w) { return __uint_as_float(w << 16); }
DI float bfhi(unsigned w) { return __uint_as_float(w & 0xffff0000u); }
DI float fexp2(float x) { return __builtin_amdgcn_exp2f(x); }
DI float flog2(float x) { return __builtin_amdgcn_logf(x); }
DI float wave_sum(float v) {
#pragma unroll
    for (int o = 1; o < 64; o <<= 1) v += __shfl_xor(v, o);
    return v;
}
template <int CTRL, bool BC> DI float dppf(float old, float src) {
    return __int_as_float(__builtin_amdgcn_update_dpp(__float_as_int(old), __float_as_int(src), CTRL, 0xf, 0xf, BC));
}

namespace pg8 {
constexpr int BM = 256, BK = 64, HALF = 128, HTB = HALF * BK * 2, STAGE_BYTES = 8 * HTB, NXCD = 8, WGM = 8;
DI int lds_byte(int r, int c) { const int st = (r >> 4) * 2 + (c >> 5), rr = r & 15, cc = c & 31, ob = rr * 64 + cc * 2; return st * 1024 + (ob ^ (((ob >> 9) & 1) << 5)); }
DI void stage_rc(int b, int& R, int& C) { const int st = b / 1024, sb = b % 1024, swz = sb ^ (((sb >> 9) & 1) << 5); R = (st >> 1) * 16 + swz / 64; C = (st & 1) * 32 + (swz % 64) / 2; }
DI int perm32(int rho) { const int n = rho >> 4, i = rho & 15; return 8 * (i >> 2) + 4 * n + (i & 3); }
struct Unit { int pm, pn; };
struct Gemm { const bf16_t* A; const bf16_t* Bt; int M, N, K; };
struct StaticOrder {
    int nM, nN, nwg, G, c;
    DI void init(int M, int N, int G_, int c_) { nM = M / BM; nN = N / BM; nwg = nM * nN; G = G_; c = c_; }
    DI bool next(int i, Unit& u) const {
        const long L = (long)i * G + c; if (L >= nwg) return false;
        int wgid = (int)L; { const int q = nwg / NXCD, r = nwg % NXCD, xcd = wgid % NXCD, off = wgid / NXCD; wgid = (xcd < r ? xcd * (q + 1) : r * (q + 1) + (xcd - r) * q) + off; }
        const int nig = WGM * nN, gid = wgid / nig, fm = gid * WGM, gsz = (nM - fm) < WGM ? (nM - fm) : WGM;
        u.pm = fm + ((wgid % nig) % gsz); u.pn = (wgid % nig) / gsz; return true;
    }
};

template <class Epi, class Sched, bool ALIGN_EPI = true, bool SP2 = true>
DI void gemm_phase(LAS unsigned char* lds, const Gemm g, const Sched& S, const Epi& E) {
    const int tid = threadIdx.x, wid = __builtin_amdgcn_readfirstlane(tid >> 6), lane = tid & 63, wr = wid >> 2, wc = wid & 3, fr = lane & 15, fq = lane >> 4;
    const int K = g.K, nt = K / BK;
    unsigned voffA[2], voffB[2];
#pragma unroll
    for (int i = 0; i < 2; ++i) { int R, C; stage_rc(tid * 16 + i * 8192, R, C); const int Rb = Epi::PERM ? ((R & ~31) + perm32(R & 31)) : R;
        const int Ra = Epi::APERM ? ((R & ~63) + 4 * (R & 15) + ((R >> 4) & 3)) : R;
        voffA[i] = (unsigned)(Ra * K + C) * 2u; voffB[i] = (unsigned)(Rb * K + C) * 2u; }
    const size_t kstep = (size_t)(BK * 2);
    const size_t hstep = (size_t)HALF * K * 2;
    const size_t tstep = 2 * hstep;
    const unsigned ldsw = (unsigned)wid * 1024u;
    const int aoff = lds_byte(wr * 64 + fr, fq * 8), boff = lds_byte(wc * 32 + fr, fq * 8);
#define PG8_SA(b, h) (((b) * 2 + (h)) * HTB)
#define PG8_SB(b, h) ((4 + (b) * 2 + (h)) * HTB)
#define PG8_STAGE(bufoff, gbase, voff) do { _Pragma("unroll") for (int _i = 0; _i < 2; ++_i) \
        __builtin_amdgcn_global_load_lds((const unsigned*)((const char*)(gbase) + (voff)[_i]), (LAS unsigned*)(lds + (bufoff) + ldsw + _i * 8192), 16, 0, 0); } while (0)
#define PG8_LDA(dst, b, h) do { _Pragma("unroll") for (int m = 0; m < 4; ++m) _Pragma("unroll") for (int k = 0; k < 2; ++k) dst[m][k] = *(const LAS bf16x8*)(lds + PG8_SA(b, h) + aoff + m * 2048 + k * 1024); } while (0)
#define PG8_LDB(dst, b, h) do { _Pragma("unroll") for (int n = 0; n < 2; ++n) _Pragma("unroll") for (int k = 0; k < 2; ++k) dst[n][k] = *(const LAS bf16x8*)(lds + PG8_SB(b, h) + boff + n * 2048 + k * 1024); } while (0)
#define PG8_MMA(ai, bj, At, Bt) do { __builtin_amdgcn_s_setprio(1); _Pragma("unroll") for (int m = 0; m < 4; ++m) _Pragma("unroll") for (int n = 0; n < 2; ++n) _Pragma("unroll") for (int k = 0; k < 2; ++k) \
        acc[ai][bj][m][n] = __builtin_amdgcn_mfma_f32_16x16x32_bf16(Bt[n][k], At[m][k], acc[ai][bj][m][n], 0, 0, 0); __builtin_amdgcn_s_setprio(0); } while (0)
#define PG8_WAIT_V(n) asm volatile("s_waitcnt vmcnt(" #n ")" ::: "memory")
#define PG8_WAIT_L(n) asm volatile("s_waitcnt lgkmcnt(" #n ")" ::: "memory")
#define PG8_BAR __builtin_amdgcn_s_barrier()
#define PG8_SCHED __builtin_amdgcn_sched_barrier(0)
    Unit cur, nxt; int ui = 0;
    if (!S.next(0, cur)) return;
    f32x4 acc[2][2][4][2];
#pragma unroll
    for (int a = 0; a < 2; ++a)
#pragma unroll
        for (int b = 0; b < 2; ++b)
#pragma unroll
            for (int m = 0; m < 4; ++m)
#pragma unroll
                for (int n = 0; n < 2; ++n) acc[a][b][m][n] = (f32x4){0.f, 0.f, 0.f, 0.f};
    bf16x8 At[4][2], B0[2][2], B1[2][2];
    const char* cA = (const char*)g.A + (size_t)cur.pm * tstep; const char* cB = (const char*)g.Bt + (size_t)cur.pn * tstep;
    if constexpr (Epi::PF) { E.prefetch(cur, 0, wid, lane); PG8_WAIT_V(0); PG8_BAR; }
    if constexpr (SP2) {
        PG8_STAGE(PG8_SB(0, 0), cB, voffB); PG8_STAGE(PG8_SB(0, 1), cB + hstep, voffB); PG8_STAGE(PG8_SA(0, 0), cA, voffA); PG8_STAGE(PG8_SA(0, 1), cA + hstep, voffA);
        if (wr == 1) PG8_BAR;
        PG8_WAIT_V(2); PG8_BAR;
        PG8_STAGE(PG8_SB(1, 0), cB + kstep, voffB); PG8_STAGE(PG8_SA(1, 0), cA + kstep, voffA); PG8_STAGE(PG8_SB(1, 1), cB + hstep + kstep, voffB);
        PG8_WAIT_V(6); PG8_BAR;
    } else {
        PG8_STAGE(PG8_SB(0, 0), cB, voffB); PG8_STAGE(PG8_SA(0, 0), cA, voffA); PG8_STAGE(PG8_SB(0, 1), cB + hstep, voffB); PG8_STAGE(PG8_SA(0, 1), cA + hstep, voffA);
        if (wr == 1) PG8_BAR;
        PG8_WAIT_V(4); PG8_BAR;
        PG8_STAGE(PG8_SB(1, 0), cB + kstep, voffB); PG8_STAGE(PG8_SA(1, 0), cA + kstep, voffA); PG8_STAGE(PG8_SB(1, 1), cB + hstep + kstep, voffB);
        PG8_WAIT_V(6); PG8_BAR;
    }
    for (;;) {
        const bool has_next = S.next(ui + 1, nxt);
        const char* nA = has_next ? (const char*)g.A + (size_t)nxt.pm * tstep : cA; const char* nB = has_next ? (const char*)g.Bt + (size_t)nxt.pn * tstep : cB;
        for (int t = 0; t < nt; t += 2) {
            const bool last = (t == nt - 2);
            const char* a1 = cA + (size_t)(t + 1) * kstep;
            const char* a2 = last ? nA : cA + (size_t)(t + 2) * kstep; const char* b2 = last ? nB : cB + (size_t)(t + 2) * kstep;
            const char* a3 = a2 + kstep; const char* b3 = b2 + kstep;
            if constexpr (SP2) {
            PG8_LDB(B0, 0, 0); PG8_LDB(B1, 0, 1); PG8_SCHED; PG8_LDA(At, 0, 0); PG8_STAGE(PG8_SA(1, 1), a1 + hstep, voffA);
            PG8_WAIT_V(8); PG8_WAIT_L(0); PG8_BAR; PG8_MMA(0, 0, At, B0); PG8_MMA(0, 1, At, B1); PG8_BAR; PG8_SCHED;
            PG8_LDA(At, 0, 1); PG8_STAGE(PG8_SB(0, 0), b2, voffB); PG8_STAGE(PG8_SB(0, 1), b2 + hstep, voffB); PG8_STAGE(PG8_SA(0, 0), a2, voffA);
            PG8_WAIT_V(8); PG8_WAIT_L(0); PG8_BAR; PG8_MMA(1, 0, At, B0); PG8_MMA(1, 1, At, B1); PG8_BAR; PG8_SCHED;
            PG8_LDB(B0, 1, 0); PG8_LDB(B1, 1, 1); PG8_SCHED; PG8_LDA(At, 1, 0); PG8_STAGE(PG8_SA(0, 1), a2 + hstep, voffA);
            PG8_WAIT_V(8); PG8_WAIT_L(0); PG8_BAR; PG8_MMA(0, 0, At, B0); PG8_MMA(0, 1, At, B1); PG8_BAR; PG8_SCHED;
            PG8_LDA(At, 1, 1); PG8_STAGE(PG8_SB(1, 0), b3, voffB); PG8_STAGE(PG8_SB(1, 1), b3 + hstep, voffB); PG8_STAGE(PG8_SA(1, 0), a3, voffA);
            PG8_WAIT_V(8); PG8_WAIT_L(0); PG8_BAR; PG8_MMA(1, 0, At, B0); PG8_MMA(1, 1, At, B1); PG8_BAR; PG8_SCHED;
            } else {
            PG8_LDB(B0, 0, 0); PG8_SCHED; PG8_LDA(At, 0, 0); PG8_STAGE(PG8_SA(1, 1), a1 + hstep, voffA);
            PG8_WAIT_L(8); PG8_BAR; PG8_WAIT_L(0); PG8_MMA(0, 0, At, B0); PG8_BAR; PG8_SCHED;
            PG8_LDB(B1, 0, 1); PG8_STAGE(PG8_SB(0, 0), b2, voffB);
            PG8_BAR; PG8_WAIT_L(0); PG8_MMA(0, 1, At, B1); PG8_BAR;
            PG8_LDA(At, 0, 1); PG8_STAGE(PG8_SA(0, 0), a2, voffA);
            PG8_BAR; PG8_WAIT_L(0); PG8_MMA(1, 0, At, B0); PG8_BAR; PG8_SCHED;
            PG8_STAGE(PG8_SB(0, 1), b2 + hstep, voffB);
            PG8_WAIT_V(6); PG8_BAR; PG8_MMA(1, 1, At, B1); PG8_BAR;
            PG8_LDB(B0, 1, 0); PG8_SCHED; PG8_LDA(At, 1, 0); PG8_STAGE(PG8_SA(0, 1), a2 + hstep, voffA);
            PG8_WAIT_L(8); PG8_BAR; PG8_WAIT_L(0); PG8_MMA(0, 0, At, B0); PG8_BAR; PG8_SCHED;
            PG8_LDB(B1, 1, 1); PG8_STAGE(PG8_SB(1, 0), b3, voffB);
            PG8_BAR; PG8_WAIT_L(0); PG8_MMA(0, 1, At, B1); PG8_BAR;
            PG8_LDA(At, 1, 1); PG8_STAGE(PG8_SA(1, 0), a3, voffA);
            PG8_BAR; PG8_WAIT_L(0); PG8_MMA(1, 0, At, B0); PG8_BAR; PG8_SCHED;
            PG8_STAGE(PG8_SB(1, 1), b3 + hstep, voffB);
            PG8_WAIT_V(6); PG8_BAR; PG8_MMA(1, 1, At, B1); PG8_BAR;
            }
        }
        if constexpr (ALIGN_EPI) { if (wr == 0) PG8_BAR; }
        if constexpr (Epi::PF) E(acc, cur, wr, wc, fr, fq, ui, has_next, nxt, wid, lane); else E(acc, cur, wr, wc, fr, fq);
        if (!has_next) break;
#pragma unroll
        for (int a = 0; a < 2; ++a)
#pragma unroll
            for (int b = 0; b < 2; ++b)
#pragma unroll
                for (int m = 0; m < 4; ++m)
#pragma unroll
                    for (int n = 0; n < 2; ++n) acc[a][b][m][n] = (f32x4){0.f, 0.f, 0.f, 0.f};
        cur = nxt; cA = nA; cB = nB; ++ui;
        if constexpr (ALIGN_EPI) { if (wr == 1) PG8_BAR; }
    }
    PG8_WAIT_V(0);
    if constexpr (!ALIGN_EPI) { if (wr == 0) PG8_BAR; }
    PG8_BAR;
#undef PG8_SA
#undef PG8_SB
#undef PG8_STAGE
#undef PG8_LDA
#undef PG8_LDB
#undef PG8_MMA
#undef PG8_WAIT_V
#undef PG8_WAIT_L
#undef PG8_BAR
#undef PG8_SCHED
}
}
using pg8::Unit;
typedef f32x4 Acc[2][2][4][2];

struct Epi1 {
    static constexpr bool PERM = true, PF = false, APERM = false;
    bf16_t* proj; float* b2; const float* rstd; const float* bgate; const float* glag;
    DI void operator()(Acc& acc, const Unit& u, int wr, int wc, int fr, int fq) const {
        const int row0 = u.pm * 256 + wr * 64 + fr;
        if (u.pn < 12) {
            const int col0 = u.pn * 256 + wc * 32 + 8 * fq;
            const bool isog = u.pn >= 10;
            f32x4 gg[2][2];
#pragma unroll
            for (int bj = 0; bj < 2; ++bj) { gg[bj][0] = isog ? *(const f32x4*)(glag + col0 - OG_OFF + bj * 128) : (f32x4){1.f, 1.f, 1.f, 1.f}; gg[bj][1] = isog ? *(const f32x4*)(glag + col0 - OG_OFF + bj * 128 + 4) : (f32x4){1.f, 1.f, 1.f, 1.f}; }
#pragma unroll
            for (int ai = 0; ai < 2; ++ai)
#pragma unroll
                for (int m = 0; m < 4; ++m) {
                    const int row = row0 + ai * 128 + m * 16; const float sc = rstd[row];
                    bf16_t* rowp = proj + (size_t)row * PP + col0;
#pragma unroll
                    for (int bj = 0; bj < 2; ++bj) { f32x4 v0 = acc[ai][bj][m][0] * sc, v1 = acc[ai][bj][m][1] * sc;
                        if (isog) {
#pragma unroll
                            for (int c = 0; c < 4; ++c) { v0[c] = v0[c] * __builtin_amdgcn_rcpf(1.f + fexp2(-v0[c] * LOG2E)) * gg[bj][0][c]; v1[c] = v1[c] * __builtin_amdgcn_rcpf(1.f + fexp2(-v1[c] * LOG2E)) * gg[bj][1][c]; }
                        }
                        u32x4 w; w.x = cvt_pk_bf16(v0[0], v0[1]); w.y = cvt_pk_bf16(v0[2], v0[3]); w.z = cvt_pk_bf16(v1[0], v1[1]); w.w = cvt_pk_bf16(v1[2], v1[3]);
                        *(u32x4*)(rowp + bj * 128) = w; }
                }
        } else {
            const int c0 = wc * 32 + 8 * fq;
            const int lane = threadIdx.x & 63;
#pragma unroll
            for (int ai = 0; ai < 2; ++ai) {
                float sc[4];
#pragma unroll
                for (int m = 0; m < 4; ++m) sc[m] = rstd[row0 + ai * 128 + m * 16];
#pragma unroll
                for (int bj = 0; bj < 2; ++bj)
#pragma unroll
                    for (int n = 0; n < 2; ++n) {
                        const int cc = c0 + 128 * bj + 4 * n;
                        const f32x4 bias = *(const f32x4*)(bgate + cc);
                        f32x4 carry = {0.f, 0.f, 0.f, 0.f};
#pragma unroll
                        for (int m = 0; m < 4; ++m) {
                            const f32x4 v = acc[ai][bj][m][n] * sc[m] + bias;
                            f32x4 la;
#pragma unroll
                            for (int c = 0; c < 4; ++c) {
                                const float x = v[c];
                                float l = fminf(x, 0.f) * LOG2E - flog2(1.f + fexp2(-fabsf(x) * LOG2E));
                                l *= (1.0f / 16.0f);
                                l += dppf<0x111, true>(0.f, l);
                                l += dppf<0x112, true>(0.f, l);
                                l += dppf<0x114, true>(0.f, l);
                                l += dppf<0x118, true>(0.f, l);
                                l += carry[c];
                                carry[c] = __shfl(l, (lane & 48) | 15);
                                la[c] = l;
                            }
                            *(f32x4*)(b2 + (size_t)(row0 + ai * 128 + m * 16) * 256 + cc) = la;
                        }
                    }
            }
        }
    }
};

template <bool WB> struct EpiRes {
    static constexpr bool PERM = true, PF = false, APERM = false;
    const float* base; float* out; bf16_t* outb; float* ssq; const bf16_t* baseb;
    DI void operator()(Acc& acc, const Unit& u, int wr, int wc, int fr, int fq) const {
        const int row0 = u.pm * 256 + wr * 64 + fr, col0 = u.pn * 256 + wc * 32 + 8 * fq;
#pragma unroll
        for (int ai = 0; ai < 2; ++ai)
#pragma unroll
            for (int m = 0; m < 4; ++m) {
                const int row = row0 + ai * 128 + m * 16; const size_t off = (size_t)row * D + col0; float s = 0.f;
#pragma unroll
                for (int bj = 0; bj < 2; ++bj) {
                    f32x4 b0, b1;
                    if (baseb) { const u32x4 rb = *(const u32x4*)(baseb + off + bj * 128); b0 = (f32x4){bflo(rb.x), bfhi(rb.x), bflo(rb.y), bfhi(rb.y)}; b1 = (f32x4){bflo(rb.z), bfhi(rb.z), bflo(rb.w), bfhi(rb.w)}; }
                    else { b0 = *(const f32x4*)(base + off + bj * 128); b1 = *(const f32x4*)(base + off + bj * 128 + 4); }
                    const f32x4 v0 = acc[ai][bj][m][0] + b0, v1 = acc[ai][bj][m][1] + b1;
                    if (out) { *(f32x4*)(out + off + bj * 128) = v0; *(f32x4*)(out + off + bj * 128 + 4) = v1; }
                    s += (v0[0] * v0[0] + v0[1] * v0[1]) + (v0[2] * v0[2] + v0[3] * v0[3]) + (v1[0] * v1[0] + v1[1] * v1[1]) + (v1[2] * v1[2] + v1[3] * v1[3]);
                    if (WB) { u32x4 w; w.x = cvt_pk_bf16(v0[0], v0[1]); w.y = cvt_pk_bf16(v0[2], v0[3]); w.z = cvt_pk_bf16(v1[0], v1[1]); w.w = cvt_pk_bf16(v1[2], v1[3]);
                        *(u32x4*)(outb + off + bj * 128) = w; }
                }
                s += __shfl_xor(s, 16); s += __shfl_xor(s, 32);
                if (fq == 0) atomicAdd(ssq + row, s);
            }
    }
};

DI f32x4 rot_prev(const f32x4& cur, const f32x4& prev, int fr, int which) {
    f32x4 r;
#pragma unroll
    for (int c = 0; c < 4; ++c) {
        if (which == 1) { const float t = dppf<0x10F, true>(0.f, prev[c]); r[c] = dppf<0x111, false>(t, cur[c]); }
        else            { const float t = dppf<0x10E, true>(0.f, prev[c]); r[c] = dppf<0x112, false>(t, cur[c]); }
    }
    return r;
}
struct Epi3 {
    static constexpr bool PERM = true, PF = true, APERM = true;
    bf16_t* g; const float* ssq2; const float* convw; const float* convb; float* hhead; float* htail; LAS float* halo; LAS unsigned char* pf;
    DI void prefetch(const Unit& u, int par, int wid, int lane) const {
        LAS unsigned char* buf = pf + par * 5120;
        if (wid < 4) {
            const int k = 2 * wid + (lane >> 5), chunk = lane & 31, kk = k & 3;
            const float* src = (kk == 3 ? convb : convw + kk * NU) + (k >= 4 ? DFF : 0) + u.pn * 128 + 4 * chunk;
            __builtin_amdgcn_global_load_lds((const unsigned*)src, (LAS unsigned*)(buf + wid * 1024), 16, 0, 0);
        } else if (wid == 4) {
            __builtin_amdgcn_global_load_lds((const unsigned*)(ssq2 + u.pm * 256 + 4 * lane), (LAS unsigned*)(buf + 4096), 16, 0, 0);
        }
    }
    DI void operator()(Acc& acc, const Unit& u, int wr, int wc, int fr, int fq, int ui, bool has_next, const Unit& nxt, int wid, int lane) const {
        const int rowb = u.pm * 256 + wr * 64 + 4 * fr;
        const int cl = wc * 32 + 8 * fq;
        if (has_next) prefetch(nxt, (ui + 1) & 1, wid, lane);
        const LAS unsigned char* cb = pf + (ui & 1) * 5120;
#pragma unroll
        for (int ai = 0; ai < 2; ++ai) {
            const f32x4 sq = *(const LAS f32x4*)(cb + 4096 + (ai * 128 + wr * 64 + 4 * fr) * 4);
#pragma unroll
            for (int m = 0; m < 4; ++m) { const float sc = __builtin_amdgcn_rsqf(sq[m] * (1.0f / D) + EPS);
#pragma unroll
                for (int bj = 0; bj < 2; ++bj) { acc[ai][bj][m][0] *= sc; acc[ai][bj][m][1] *= sc; } } }
        if (fr == 15) {
#pragma unroll
            for (int ai = 0; ai < 2; ++ai)
#pragma unroll
                for (int r = 0; r < 2; ++r) {
                    LAS float* hp = halo + ((2 * ai + wr + 1) * 2 + r) * 256 + cl;
#pragma unroll
                    for (int bj = 0; bj < 2; ++bj) { *(LAS f32x4*)(hp + bj * 128) = acc[ai][bj][2 + r][0]; *(LAS f32x4*)(hp + bj * 128 + 4) = acc[ai][bj][2 + r][1]; }
                }
            if (wr == 0) { const f32x4 z = {0.f, 0.f, 0.f, 0.f};
#pragma unroll
                for (int r = 0; r < 2; ++r) { LAS float* hp = halo + r * 256 + cl; *(LAS f32x4*)(hp) = z; *(LAS f32x4*)(hp + 4) = z; *(LAS f32x4*)(hp + 128) = z; *(LAS f32x4*)(hp + 132) = z; } }
            if (wr == 1) {
#pragma unroll
                for (int r = 0; r < 2; ++r) { float* tp = htail + ((size_t)u.pm * 2 + r) * NU + u.pn * 256 + cl;
#pragma unroll
                    for (int bj = 0; bj < 2; ++bj) { *(f32x4*)(tp + bj * 128) = acc[1][bj][2 + r][0]; *(f32x4*)(tp + bj * 128 + 4) = acc[1][bj][2 + r][1]; } } }
        }
        if (fr == 0 && wr == 0) {
#pragma unroll
            for (int r = 0; r < 2; ++r) { float* tp = hhead + ((size_t)u.pm * 2 + r) * NU + u.pn * 256 + cl;
#pragma unroll
                for (int bj = 0; bj < 2; ++bj) { *(f32x4*)(tp + bj * 128) = acc[0][bj][r][0]; *(f32x4*)(tp + bj * 128 + 4) = acc[0][bj][r][1]; } } }
        asm volatile("s_waitcnt lgkmcnt(0)" ::: "memory"); __builtin_amdgcn_s_barrier(); asm volatile("" ::: "memory");
        const int ch = u.pn * 128 + cl;
#pragma unroll
        for (int n = 0; n < 2; ++n) {
            const LAS unsigned char* cp = cb + (cl + 4 * n) * 4;
            const f32x4 wa0 = *(const LAS f32x4*)(cp), wa1 = *(const LAS f32x4*)(cp + 512), wa2 = *(const LAS f32x4*)(cp + 1024), ba = *(const LAS f32x4*)(cp + 1536);
            const f32x4 wv0 = *(const LAS f32x4*)(cp + 2048), wv1 = *(const LAS f32x4*)(cp + 2560), wv2 = *(const LAS f32x4*)(cp + 3072), bv = *(const LAS f32x4*)(cp + 3584);
#pragma unroll
            for (int ai = 0; ai < 2; ++ai) {
                asm volatile("" ::: "memory"); __builtin_amdgcn_sched_barrier(0);
                f32x4 ha1 = {0.f, 0.f, 0.f, 0.f}, ha2 = ha1, hv1 = ha1, hv2 = ha1;
                if (fr == 0) { const LAS float* hp = halo + ((2 * ai + wr) * 2) * 256 + cl + 4 * n;
                    ha2 = *(const LAS f32x4*)hp; hv2 = *(const LAS f32x4*)(hp + 128); ha1 = *(const LAS f32x4*)(hp + 256); hv1 = *(const LAS f32x4*)(hp + 384); }
                f32x4 pa1, pa2, pv1, pv2;
#pragma unroll
                for (int c = 0; c < 4; ++c) {
                    pa1[c] = dppf<0x111, false>(ha1[c], acc[ai][0][3][n][c]); pa2[c] = dppf<0x111, false>(ha2[c], acc[ai][0][2][n][c]);
                    pv1[c] = dppf<0x111, false>(hv1[c], acc[ai][1][3][n][c]); pv2[c] = dppf<0x111, false>(hv2[c], acc[ai][1][2][n][c]);
                }
                asm volatile("" : "+v"(pa1), "+v"(pa2), "+v"(pv1), "+v"(pv2));
#pragma unroll
                for (int m = 0; m < 4; ++m) {
                    asm volatile("" : "+v"(acc[ai][0][m][n]), "+v"(acc[ai][1][m][n]), "+v"(pa1), "+v"(pv1));
                    const f32x4 ca = acc[ai][0][m][n], cv = acc[ai][1][m][n];
                    const f32x4 a = ba + wa0 * pa2 + wa1 * pa1 + wa2 * ca;
                    const f32x4 v = bv + wv0 * pv2 + wv1 * pv1 + wv2 * cv;
                    f32x4 o;
#pragma unroll
                    for (int c = 0; c < 4; ++c) o[c] = a[c] * v[c] * __builtin_amdgcn_rcpf(1.f + fexp2(-a[c] * LOG2E));
                    acc[ai][0][m][n] = o; pa2 = pa1; pv2 = pv1; pa1 = ca; pv1 = cv;
                    asm volatile("" : "+v"(acc[ai][0][m][n]));
                }
            }
        }
#pragma unroll
        for (int ai = 0; ai < 2; ++ai)
#pragma unroll
            for (int m = 0; m < 4; ++m) { const f32x4 v0 = acc[ai][0][m][0], v1 = acc[ai][0][m][1];
                u32x4 w; w.x = cvt_pk_bf16(v0[0], v0[1]); w.y = cvt_pk_bf16(v0[2], v0[3]); w.z = cvt_pk_bf16(v1[0], v1[1]); w.w = cvt_pk_bf16(v1[2], v1[3]);
                *(u32x4*)(g + (size_t)(rowb + ai * 128 + m) * DFF + ch) = w; }
    }
};

struct Epi4F {
    static constexpr bool PERM = true, PF = false, APERM = false;
    const float* base; const bf16_t* baseb; float* out; const float* gfin; float* xbuf; unsigned* cnt; LAS float* scr;
    DI void operator()(Acc& acc, const Unit& u, int wr, int wc, int fr, int fq) const {
        const int tid = threadIdx.x, lane = tid & 63;
        const int row0 = u.pm * 256 + wr * 64 + fr, col0 = u.pn * 256 + wc * 32 + 8 * fq;
        LAS float* part = scr; LAS float* S = scr + 1024;
#pragma unroll
        for (int ai = 0; ai < 2; ++ai)
#pragma unroll
            for (int m = 0; m < 4; ++m) {
                const size_t off = (size_t)(row0 + ai * 128 + m * 16) * D + col0; float s = 0.f;
#pragma unroll
                for (int bj = 0; bj < 2; ++bj) {
                    f32x4 b0, b1;
                    if (baseb) { const u32x4 rb = *(const u32x4*)(baseb + off + bj * 128); b0 = (f32x4){bflo(rb.x), bfhi(rb.x), bflo(rb.y), bfhi(rb.y)}; b1 = (f32x4){bflo(rb.z), bfhi(rb.z), bflo(rb.w), bfhi(rb.w)}; }
                    else { b0 = *(const f32x4*)(base + off + bj * 128); b1 = *(const f32x4*)(base + off + bj * 128 + 4); }
                    const f32x4 v0 = acc[ai][bj][m][0] + b0, v1 = acc[ai][bj][m][1] + b1;
                    acc[ai][bj][m][0] = v0; acc[ai][bj][m][1] = v1;
                    s += (v0[0] * v0[0] + v0[1] * v0[1]) + (v0[2] * v0[2] + v0[3] * v0[3]) + (v1[0] * v1[0] + v1[1] * v1[1]) + (v1[2] * v1[2] + v1[3] * v1[3]);
                }
                s += __shfl_xor(s, 16); s += __shfl_xor(s, 32);
                if (fq == 0) part[wc * 256 + ai * 128 + wr * 64 + m * 16 + fr] = s;
                if (m & 1) asm volatile("" ::: "memory");
            }
        asm volatile("s_waitcnt lgkmcnt(0)" ::: "memory"); __builtin_amdgcn_s_barrier(); asm volatile("" ::: "memory");
        unsigned* cw = cnt + 64 * u.pm;
        if (tid < 256) {
            const float tot = (part[tid] + part[256 + tid]) + (part[512 + tid] + part[768 + tid]);
            __hip_atomic_store(xbuf + ((size_t)u.pm * 4 + u.pn) * 256 + tid, tot, __ATOMIC_RELAXED, __HIP_MEMORY_SCOPE_AGENT);
            asm volatile("s_waitcnt vmcnt(0)" ::: "memory");
            if (lane == 0) __hip_atomic_fetch_add(cw, 1u, __ATOMIC_RELAXED, __HIP_MEMORY_SCOPE_AGENT);
        }
        if (tid == 0) {
            unsigned spins = 0;
            while (__hip_atomic_load(cw, __ATOMIC_RELAXED, __HIP_MEMORY_SCOPE_AGENT) < 16u) { __builtin_amdgcn_s_sleep(2); if (++spins > (1u << 24)) break; }
            __builtin_amdgcn_fence(__ATOMIC_ACQUIRE, "agent");
        }
        asm volatile("s_waitcnt vmcnt(0) lgkmcnt(0)" ::: "memory"); __builtin_amdgcn_s_barrier(); asm volatile("" ::: "memory");
        if (tid < 256) {
            const float* sl = xbuf + (size_t)u.pm * 4 * 256 + tid;
            const float t = (__hip_atomic_load(sl, __ATOMIC_RELAXED, __HIP_MEMORY_SCOPE_AGENT) + __hip_atomic_load(sl + 256, __ATOMIC_RELAXED, __HIP_MEMORY_SCOPE_AGENT))
                          + (__hip_atomic_load(sl + 512, __ATOMIC_RELAXED, __HIP_MEMORY_SCOPE_AGENT) + __hip_atomic_load(sl + 768, __ATOMIC_RELAXED, __HIP_MEMORY_SCOPE_AGENT));
            S[tid] = 1.0f / sqrtf(t * (1.0f / D) + EPS);
        }
        asm volatile("s_waitcnt lgkmcnt(0)" ::: "memory"); __builtin_amdgcn_s_barrier(); asm volatile("" ::: "memory");
        f32x4 gv[2][2];
#pragma unroll
        for (int bj = 0; bj < 2; ++bj) { gv[bj][0] = *(const f32x4*)(gfin + col0 + bj * 128); gv[bj][1] = *(const f32x4*)(gfin + col0 + bj * 128 + 4); }
#pragma unroll
        for (int ai = 0; ai < 2; ++ai)
#pragma unroll
            for (int m = 0; m < 4; ++m) {
                const float rs = S[ai * 128 + wr * 64 + m * 16 + fr]; const size_t off = (size_t)(row0 + ai * 128 + m * 16) * D + col0;
#pragma unroll
                for (int bj = 0; bj < 2; ++bj) { *(f32x4*)(out + off + bj * 128) = acc[ai][bj][m][0] * rs * gv[bj][0]; *(f32x4*)(out + off + bj * 128 + 4) = acc[ai][bj][m][1] * rs * gv[bj][1]; }
            }
    }
};


#define RLX_AGENT __ATOMIC_RELAXED, __HIP_MEMORY_SCOPE_AGENT
#define XB_TMO      128
#define XB_XCNT(j)  (256  + 64 * (j))
#define XB_XSUB(j)  (1280 + 64 * (j))
#define XB_XGEN(j)  (2304 + 64 * (j))
#define XB_TOP      3328
#define XB_TOPGEN   3392
#define XCD_BAR_WORDS 3456
#define XB_SPIN_CAP (1u << 18)

__device__ __forceinline__ unsigned xb_ld(unsigned* p)              { return __hip_atomic_load(p, __ATOMIC_RELAXED, __HIP_MEMORY_SCOPE_AGENT); }
__device__ __forceinline__ unsigned xb_add(unsigned* p, unsigned v) { return __hip_atomic_fetch_add(p, v, __ATOMIC_RELAXED, __HIP_MEMORY_SCOPE_AGENT); }
__device__ __forceinline__ unsigned xb_xcc_id() { return (unsigned)__builtin_amdgcn_s_getreg((3 << 11) | 20) & 0xFu; }
#define XB_SPIN(cond, bar) do { unsigned _sp = 0; while (cond) { __builtin_amdgcn_s_sleep(1); \
    if ((++_sp & 255u) == 0u) { if (xb_ld(&(bar)[XB_TMO])) break; if (_sp > XB_SPIN_CAP) { atomicAdd(&(bar)[XB_TMO], 1u); break; } } } } while (0)

struct XcdBarrier {
    unsigned* bar; unsigned x;
    volatile LAS unsigned* st;
};

__device__ __forceinline__ XcdBarrier xcd_barrier_post(unsigned* bar, volatile LAS unsigned* st) {
    XcdBarrier b; b.bar = bar; b.x = xb_xcc_id(); b.st = st;
    if (threadIdx.x == 0) st[2] = xb_add(&bar[XB_XCNT(b.x)], 1u);
    return b;
}
__device__ __forceinline__ void xcd_barrier_complete(unsigned* bar, unsigned x, unsigned& nloc, unsigned& nx, unsigned& even32) {
    const unsigned G = gridDim.x * gridDim.y * gridDim.z;
    unsigned sum, cnt, mine, sp = 0u;
    for (;;) {
        sum = 0u; cnt = 0u; mine = 0u; unsigned ok = 1u;
#pragma unroll
        for (unsigned j = 0; j < 16; ++j) { const unsigned c = xb_ld(&bar[XB_XCNT(j)]); sum += c; cnt += (c > 0u) ? 1u : 0u; mine = (j == x) ? c : mine; ok &= (c == (j < 8u ? 32u : 0u)) ? 1u : 0u; }
        even32 = ok;
        if (sum == G) break;
        __builtin_amdgcn_s_sleep(1);
        if ((++sp & 255u) == 0u) { if (xb_ld(&bar[XB_TMO])) break; if (sp > XB_SPIN_CAP) { atomicAdd(&bar[XB_TMO], 1u); break; } }
    }
    nloc = mine > 0u ? mine : 1u; nx = cnt > 0u ? cnt : 1u;
}

__device__ __forceinline__ void xcd_barrier(const XcdBarrier& b) {
    asm volatile("s_waitcnt vmcnt(0)" ::: "memory");
    __syncthreads();
    if (threadIdx.x == 0) {
        unsigned* bar = b.bar;
        __builtin_amdgcn_s_waitcnt(0);
        unsigned nloc = b.st[0], nx = b.st[1];
        if (nloc == 0u) { unsigned e32 = 0u; xcd_barrier_complete(bar, b.x, nloc, nx, e32); b.st[0] = nloc; b.st[1] = nx; b.st[3] = e32; }
        const unsigned old = xb_add(&bar[XB_XSUB(b.x)], 1u);
        const unsigned gen = old / nloc;
        if (old + 1u == (gen + 1u) * nloc) {
            __builtin_amdgcn_fence(__ATOMIC_RELEASE, "agent");
            asm volatile("s_waitcnt vmcnt(0)" ::: "memory");
            const unsigned og = xb_add(&bar[XB_TOP], 1u);
            const unsigned tg = og / nx;
            if (og + 1u == (tg + 1u) * nx) xb_add(&bar[XB_TOPGEN], 1u);
            else XB_SPIN(xb_ld(&bar[XB_TOPGEN]) == tg, bar);
            __builtin_amdgcn_fence(__ATOMIC_ACQUIRE, "agent");
            xb_add(&bar[XB_XGEN(b.x)], 1u);
            asm volatile("s_waitcnt vmcnt(0)" ::: "memory");
        } else {
            XB_SPIN(xb_ld(&bar[XB_XGEN(b.x)]) == gen, bar);
            __builtin_amdgcn_fence(__ATOMIC_ACQUIRE, "agent");
            asm volatile("s_waitcnt vmcnt(0)" ::: "memory");
        }
    }
    __syncthreads();
}

struct Args {
    const float* x; const float* attn_g; const float* w_in; const float* w_gate_up; const float* b_gate_up; const float* sb_g; const float* gla_g; const float* w_out;
    const float* ffn_g; const float* w_up; const float* conv_w; const float* conv_b; const float* w_down; const float* final_g;
    float* out; unsigned char* ws; int ph_lo, ph_hi, coop, pad;
};

DI void tr_item(const float* src, int ldsrc, const float* gain, float cscale, bf16_t* dst, int lddst, LAS float* scr, int lane) {
    {
        const f32x4* sp = (const f32x4*)(src + (size_t)lane * ldsrc); const float gs = gain ? gain[lane] * cscale : cscale;
        f32x4 v[8];
#pragma unroll
        for (int j = 0; j < 8; ++j) v[j] = sp[j];
#pragma unroll
        for (int j = 0; j < 8; ++j)
#pragma unroll
            for (int e = 0; e < 4; ++e) scr[lane * 33 + 4 * j + e] = v[j][e] * gs;
    }
    asm volatile("s_waitcnt lgkmcnt(0)" ::: "memory");
    const int c = lane & 7;
#pragma unroll
    for (int j = 0; j < 4; ++j) { const int n = (lane >> 3) + 8 * j; const LAS float* s = scr + (8 * c) * 33 + n;
        u32x4 o; o.x = cvt_pk_bf16(s[0 * 33], s[1 * 33]); o.y = cvt_pk_bf16(s[2 * 33], s[3 * 33]); o.z = cvt_pk_bf16(s[4 * 33], s[5 * 33]); o.w = cvt_pk_bf16(s[6 * 33], s[7 * 33]);
        *(u32x4*)(dst + (size_t)n * lddst + 8 * c) = o; }
    asm volatile("s_waitcnt lgkmcnt(0)" ::: "memory");
}
DI void phase_prep(const Args& a, LAS unsigned char* lds) {
    const int tid = threadIdx.x, lane = tid & 63, wave = tid >> 6;
    const int gw = blockIdx.x * 8 + wave, NGW = gridDim.x * 8;
    LAS float* scr = (LAS float*)(lds + wave * 16384);
    bf16_t* Win = (bf16_t*)(a.ws + WS_WIN); bf16_t* Wout = (bf16_t*)(a.ws + WS_WOUT); bf16_t* Wup = (bf16_t*)(a.ws + WS_WUP); bf16_t* Wdn = (bf16_t*)(a.ws + WS_WDN);
    constexpr int I_IN = 16 * 96, I_OUT = 16 * 32, I_UP = 16 * 176, I_DN = 44 * 32, NIT = I_IN + I_OUT + I_UP + I_DN;
    for (int it = gw; it < NIT; it += NGW) {
        int r = it;
        if (r < I_IN) { const int kb = r / 96, nb = r % 96, k0 = 64 * kb, n0 = 32 * nb, c0 = n0 < 2560 ? n0 : n0 + 16;
            tr_item(a.w_in + (size_t)k0 * 3088 + c0, 3088, a.attn_g + k0, n0 < 512 ? QSCALE : 1.0f, Win + (size_t)n0 * D + k0, D, scr, lane); continue; }
        r -= I_IN;
        if (r < I_OUT) { const int kb = r / 32, nb = r % 32, k0 = 64 * kb, n0 = 32 * nb;
            tr_item(a.w_out + (size_t)k0 * D + n0, D, nullptr, 1.0f, Wout + (size_t)n0 * D + k0, D, scr, lane); continue; }
        r -= I_OUT;
        if (r < I_UP) { const int kb = r / 176, nb = r % 176, k0 = 64 * kb, n0 = 32 * nb, j = n0 >> 8, w = n0 & 255, c0 = w < 128 ? 128 * j + w : DFF + 128 * j + (w - 128);
            tr_item(a.w_up + (size_t)k0 * NU + c0, NU, a.ffn_g + k0, 1.0f, Wup + (size_t)n0 * D + k0, D, scr, lane); continue; }
        r -= I_UP;
        { const int kb = r / 32, nb = r % 32, k0 = 64 * kb, n0 = 32 * nb;
            tr_item(a.w_down + (size_t)k0 * D + n0, D, nullptr, 1.0f, Wdn + (size_t)n0 * DFF + k0, DFF, scr, lane); }
    }
    for (int it = blockIdx.x * 512 + tid; it < 256 * 128; it += gridDim.x * 512) {
        const int n = it >> 7, k0 = (it & 127) * 8;
        float wg[16];
#pragma unroll
        for (int r = 0; r < 16; ++r) wg[r] = a.w_gate_up[r * 256 + n];
        float o[8];
#pragma unroll
        for (int kk = 0; kk < 8; ++kk) { const float* wr_ = a.w_in + (size_t)(k0 + kk) * 3088 + 2560; float s = 0.f;
#pragma unroll
            for (int r4 = 0; r4 < 4; ++r4) { const f32x4 w4 = *(const f32x4*)(wr_ + 4 * r4); s += w4[0] * wg[4 * r4] + w4[1] * wg[4 * r4 + 1] + w4[2] * wg[4 * r4 + 2] + w4[3] * wg[4 * r4 + 3]; }
            o[kk] = s * a.attn_g[k0 + kk]; }
        u32x4 w; w.x = cvt_pk_bf16(o[0], o[1]); w.y = cvt_pk_bf16(o[2], o[3]); w.z = cvt_pk_bf16(o[4], o[5]); w.w = cvt_pk_bf16(o[6], o[7]);
        *(u32x4*)(Win + (size_t)(3072 + n) * D + k0) = w;
    }
    for (int it = gw; it < 2048; it += NGW) {
        const int kp = it & 7, cgp = (it >> 3) & 7, b = it >> 6, col = (cgp < 4 ? 1536 + 64 * cgp : 1792 + 64 * (cgp - 4)) + lane;
        const float* xr = a.x + (size_t)b * SEQ * D + 128 * kp; const float* gr = a.attn_g + 128 * kp; const float* wr_ = a.w_in + (size_t)(128 * kp) * 3088 + col;
        float s0 = 0.f, s1 = 0.f, s2 = 0.f, s3 = 0.f;
#pragma unroll 8
        for (int k = 0; k < 128; k += 4) {
            s0 += xr[k] * gr[k] * wr_[(size_t)k * 3088];
            s1 += xr[k + 1] * gr[k + 1] * wr_[(size_t)(k + 1) * 3088];
            s2 += xr[k + 2] * gr[k + 2] * wr_[(size_t)(k + 2) * 3088];
            s3 += xr[k + 3] * gr[k + 3] * wr_[(size_t)(k + 3) * 3088];
        }
        ((float*)(a.ws + WS_QK0))[(kp * 32 + b) * 512 + cgp * 64 + lane] = (s0 + s1) + (s2 + s3);
    }
    bf16_t* xb = (bf16_t*)(a.ws + WS_XB); float* rstd1 = (float*)(a.ws + WS_RSTD1);
    for (int m = gw; m < T; m += NGW) {
        const f32x4* xr = (const f32x4*)(a.x + (size_t)m * D) + lane; f32x4 v[4]; float s = 0.f;
#pragma unroll
        for (int j = 0; j < 4; ++j) { v[j] = xr[64 * j]; s += (v[j][0] * v[j][0] + v[j][1] * v[j][1]) + (v[j][2] * v[j][2] + v[j][3] * v[j][3]); }
        s = wave_sum(s);
        if (lane == 0) rstd1[m] = 1.0f / sqrtf(s * (1.0f / D) + EPS);
        u32x2* o8 = (u32x2*)(xb + (size_t)m * D) + lane;
#pragma unroll
        for (int j = 0; j < 4; ++j) { u32x2 w; w.x = cvt_pk_bf16(v[j][0], v[j][1]); w.y = cvt_pk_bf16(v[j][2], v[j][3]); o8[64 * j] = w; }
    }
}

#ifndef USE_TR
#define USE_TR 1
#endif
DI s16x4 gather4(const LAS unsigned char* base, int pitchB, int row0, int cbase, int lane) {
#if USE_TR
    const int i = lane & 15;
    const LAS unsigned char* p = base + (row0 + (i >> 2)) * pitchB + (cbase + 4 * (i & 3)) * 2;
    return __builtin_amdgcn_ds_read_tr16_b64_v4i16((LAS s16x4*)p);
#else
    const LAS unsigned char* p = base + row0 * pitchB + (cbase + (lane & 15)) * 2;
    s16x4 r;
    r[0] = *(const LAS short*)(p); r[1] = *(const LAS short*)(p + pitchB); r[2] = *(const LAS short*)(p + 2 * pitchB); r[3] = *(const LAS short*)(p + 3 * pitchB);
    return r;
#endif
}
DI bf16x8 cat8(s16x4 lo, s16x4 hi) { return __builtin_shufflevector(lo, hi, 0, 1, 2, 3, 4, 5, 6, 7); }
DI bf16x8 pack8(float a0, float a1, float a2, float a3, float a4, float a5, float a6, float a7) {
    u32x4 w; w.x = cvt_pk_bf16(a0, a1); w.y = cvt_pk_bf16(a2, a3); w.z = cvt_pk_bf16(a4, a5); w.w = cvt_pk_bf16(a6, a7); return __builtin_bit_cast(bf16x8, w);
}

constexpr float SB_CUT = 5.421010862427522e-20f;
constexpr int VPITCH = 144;
DI void sb_wave(const bf16_t* proj, bf16_t* ocat, const float* sbg, int b, int h, int q0, LAS unsigned char* vl, int lane) {
    const int r32 = lane & 31, h2 = lane >> 5;
    const size_t rowbase = (size_t)b * SEQ;
    bf16x8 qf[4];
    { const bf16_t* qp = proj + (rowbase + q0 + r32) * PP + Q_OFF + h * 64 + 8 * h2;
#pragma unroll
      for (int s = 0; s < 4; ++s) qf[s] = *(const bf16x8*)(qp + 16 * s); }
    f32x4 gsb[2][4];
#pragma unroll
    for (int dt = 0; dt < 2; ++dt)
#pragma unroll
        for (int gi = 0; gi < 4; ++gi) gsb[dt][gi] = *(const f32x4*)(sbg + h * 64 + 32 * dt + 8 * gi + 4 * h2);
    f32x16 o0, o1;
#pragma unroll
    for (int r = 0; r < 16; ++r) { o0[r] = 0.f; o1[r] = 0.f; }
    float carry = 1.f;
    const int grp = (lane >> 4) & 1;
    bf16x8 kn[4]; u32x4 vn0, vn1, vn2, vn3;
    { const int k0 = q0;
      const bf16_t* kp = proj + (rowbase + k0 + r32) * PP + K_OFF + h * 64 + 8 * h2;
#pragma unroll
      for (int s = 0; s < 4; ++s) kn[s] = *(const bf16x8*)(kp + 16 * s);
      const bf16_t* vp = proj + (rowbase + k0 + (lane >> 1)) * PP + V_OFF + h * 64 + 32 * (lane & 1);
      vn0 = *(const u32x4*)(vp); vn1 = *(const u32x4*)(vp + 8); vn2 = *(const u32x4*)(vp + 16); vn3 = *(const u32x4*)(vp + 24); }
    for (int kt = q0 >> 5; kt >= 0; --kt) {
        const int k0 = kt * 32; const bool diag = (k0 == q0);
        bf16x8 kf[4];
#pragma unroll
        for (int s = 0; s < 4; ++s) kf[s] = kn[s];
        { LAS unsigned char* dp = vl + (lane >> 1) * VPITCH + 64 * (lane & 1);
          *(LAS u32x4*)(dp) = vn0; *(LAS u32x4*)(dp + 16) = vn1; *(LAS u32x4*)(dp + 32) = vn2; *(LAS u32x4*)(dp + 48) = vn3; }
        if (kt > 0) {
            const int k1 = k0 - 32;
            const bf16_t* kp = proj + (rowbase + k1 + r32) * PP + K_OFF + h * 64 + 8 * h2;
#pragma unroll
            for (int s = 0; s < 4; ++s) kn[s] = *(const bf16x8*)(kp + 16 * s);
            const bf16_t* vp = proj + (rowbase + k1 + (lane >> 1)) * PP + V_OFF + h * 64 + 32 * (lane & 1);
            vn0 = *(const u32x4*)(vp); vn1 = *(const u32x4*)(vp + 8); vn2 = *(const u32x4*)(vp + 16); vn3 = *(const u32x4*)(vp + 24);
        }
        f32x16 z;
#pragma unroll
        for (int r = 0; r < 16; ++r) z[r] = 0.f;
#pragma unroll
        for (int s = 0; s < 4; ++s) z = __builtin_amdgcn_mfma_f32_32x32x16_bf16(kf[s], qf[s], z, 0, 0, 0);
        float om[16], be[16];
#pragma unroll
        for (int r = 0; r < 16; ++r) {
            const float e = fexp2(fminf(z[r], 80.f)); const float rc = __builtin_amdgcn_rcpf(1.f + e);
            float b_ = e * rc, o_ = rc;
            if (diag) { const int kvl = (r & 3) + 8 * (r >> 2) + 4 * h2; if (kvl >= r32) { b_ = 0.f; o_ = 1.f; } }
            be[r] = b_; om[r] = o_;
        }
        float sg[4], ps[4];
#pragma unroll
        for (int gi = 0; gi < 4; ++gi) { sg[gi] = (om[4 * gi] * om[4 * gi + 1]) * (om[4 * gi + 2] * om[4 * gi + 3]); ps[gi] = __shfl_xor(sg[gi], 32); }
        float e[4]; float run = 1.f;
#pragma unroll
        for (int gi = 3; gi >= 0; --gi) {
            const float hi = h2 ? sg[gi] : ps[gi], lo = h2 ? ps[gi] : sg[gi];
            const float e_hi = run; run *= hi; const float e_lo = run; run *= lo;
            e[gi] = h2 ? e_hi : e_lo;
        }
        float w[16];
#pragma unroll
        for (int gi = 0; gi < 4; ++gi) {
            float A = carry * e[gi];
#pragma unroll
            for (int j = 3; j >= 0; --j) { const int r = 4 * gi + j; w[r] = be[r] * A; A *= om[r]; }
        }
        carry *= run;
        asm volatile("s_waitcnt lgkmcnt(0)" ::: "memory");
#pragma unroll
        for (int s = 0; s < 2; ++s) {
            const bf16x8 pf = pack8(w[8 * s], w[8 * s + 1], w[8 * s + 2], w[8 * s + 3], w[8 * s + 4], w[8 * s + 5], w[8 * s + 6], w[8 * s + 7]);
            const bf16x8 va = cat8(gather4(vl, VPITCH, 16 * s + 4 * h2, 16 * grp, lane), gather4(vl, VPITCH, 16 * s + 8 + 4 * h2, 16 * grp, lane));
            const bf16x8 vb = cat8(gather4(vl, VPITCH, 16 * s + 4 * h2, 32 + 16 * grp, lane), gather4(vl, VPITCH, 16 * s + 8 + 4 * h2, 32 + 16 * grp, lane));
            o0 = __builtin_amdgcn_mfma_f32_32x32x16_bf16(va, pf, o0, 0, 0, 0);
            o1 = __builtin_amdgcn_mfma_f32_32x32x16_bf16(vb, pf, o1, 0, 0, 0);
        }
        asm volatile("s_waitcnt lgkmcnt(0)" ::: "memory");
        if (__all(carry < SB_CUT)) break;
    }
    float ss = 0.f;
#pragma unroll
    for (int r = 0; r < 16; ++r) ss += o0[r] * o0[r] + o1[r] * o1[r];
    ss += __shfl_xor(ss, 32);
    const float rs = 1.0f / sqrtf(ss * (1.0f / 64.0f) + EPS);
    bf16_t* op = ocat + (rowbase + q0 + r32) * D + h * 64;
#pragma unroll
    for (int dt = 0; dt < 2; ++dt)
#pragma unroll
        for (int gi = 0; gi < 4; ++gi) {
            const int d = 32 * dt + 8 * gi + 4 * h2; const f32x4 gg = gsb[dt][gi];
            const f32x16& o = dt ? o1 : o0;
            u32x2 wv; wv.x = cvt_pk_bf16(o[4 * gi] * rs * gg[0], o[4 * gi + 1] * rs * gg[1]); wv.y = cvt_pk_bf16(o[4 * gi + 2] * rs * gg[2], o[4 * gi + 3] * rs * gg[3]);
            *(u32x2*)(op + d) = wv;
        }
}

constexpr int GP = 144, GVP = 272;
constexpr int G_QD = 0, G_KI = 64 * GP, G_V = 2 * 64 * GP, G_DEC = G_V + 64 * GVP, G_BUF = 36352, G_SSQ = 2 * G_BUF, G_END = G_SSQ + 2 * 8 * 64 * 4;
static_assert(G_DEC + 256 <= G_BUF && G_END <= GEMM_LDS, "GLA LDS map");
DI void gla_unit(const Args& a, int b, int h, LAS unsigned char* lds) {
    const int tid = threadIdx.x, lane = tid & 63, w = tid >> 6, c = lane & 15, g = lane >> 4;
    const bf16_t* proj = (const bf16_t*)(a.ws + WS_PROJ); const float* b2 = (const float*)(a.ws + WS_B2); bf16_t* ocat = (bf16_t*)(a.ws + WS_OCAT);
    const size_t rowbase = (size_t)b * SEQ;
    f32x4 S[4];
#pragma unroll
    for (int dt = 0; dt < 4; ++dt) S[dt] = (f32x4){0.f, 0.f, 0.f, 0.f};
    const int si = tid >> 3, sc8 = (tid & 7) * 8, sv16 = (tid & 7) * 16;
    float s00;
    {
        const float* qk0 = (const float*)(a.ws + WS_QK0) + b * 512;
        const float rs1 = ((const float*)(a.ws + WS_RSTD1))[rowbase];
        float q0 = 0.f, k0 = 0.f;
#pragma unroll
        for (int kp = 0; kp < 8; ++kp) { q0 += qk0[kp * 32 * 512 + h * 64 + lane]; k0 += qk0[kp * 32 * 512 + 256 + h * 64 + lane]; }
        s00 = wave_sum(q0 * k0) * rs1 * rs1 * 0.125f;
    }
    u32x4 pqv, pkv, pv0, pv1; f32x4 pba, pbb; u32x2 pog[4];
#define GLA_LOAD(nn) do { const size_t t0_ = rowbase + 64 * (nn), row_ = t0_ + si; \
        pqv = *(const u32x4*)(proj + row_ * PP + GQ_OFF + h * 64 + sc8); pkv = *(const u32x4*)(proj + row_ * PP + GK_OFF + h * 64 + sc8); \
        pba = *(const f32x4*)(b2 + row_ * 256 + h * 64 + sc8); pbb = *(const f32x4*)(b2 + row_ * 256 + h * 64 + sc8 + 4); \
        pv0 = *(const u32x4*)(proj + row_ * PP + GV_OFF + h * 128 + sv16); pv1 = *(const u32x4*)(proj + row_ * PP + GV_OFF + h * 128 + sv16 + 8); \
        _Pragma("unroll") for (int it_ = 0; it_ < 4; ++it_) pog[it_] = *(const u32x2*)(proj + (t0_ + 16 * it_ + c) * PP + OG_OFF + h * 128 + 16 * w + 4 * g); } while (0)
#define GLA_FINAL(nn, OV, SV) do { const size_t t0_ = rowbase + 64 * (nn); const LAS float* sq_ = (const LAS float*)(lds + G_SSQ + ((nn) & 1) * 2048); \
        _Pragma("unroll") for (int it = 0; it < 4; ++it) { const int i = 16 * it + c; float tot = 0.f; \
            _Pragma("unroll") for (int ww = 0; ww < 8; ++ww) tot += sq_[ww * 64 + i]; \
            const float rs = __builtin_amdgcn_rsqf(tot * (1.0f / 128.0f) + EPS); \
            u32x2 wv; wv.x = cvt_pk_bf16(OV[it][0] * rs * SV[it][0], OV[it][1] * rs * SV[it][1]); wv.y = cvt_pk_bf16(OV[it][2] * rs * SV[it][2], OV[it][3] * rs * SV[it][3]); \
            *(u32x2*)(ocat + (t0_ + i) * D + 512 + h * 128 + 16 * w + 4 * g) = wv; } } while (0)
    GLA_LOAD(0);
    f32x4 o_prev[4], sil_prev[4];
#pragma unroll
    for (int it = 0; it < 4; ++it) { o_prev[it] = (f32x4){0.f, 0.f, 0.f, 0.f}; sil_prev[it] = o_prev[it]; }
    for (int n = 0; n < 32; ++n) {
        LAS unsigned char* bl_ = lds + (n & 1) * G_BUF;
        f32x4 sil[4];
        {
            const u32x4 qv = pqv, kv = pkv; const f32x4 ba = pba, bb = pbb; const u32x4 v0 = pv0, v1 = pv1;
#pragma unroll
            for (int it = 0; it < 4; ++it) sil[it] = (f32x4){bflo(pog[it].x), bfhi(pog[it].x), bflo(pog[it].y), bfhi(pog[it].y)};
            asm volatile("" : "+v"(sil[0]), "+v"(sil[1]), "+v"(sil[2]), "+v"(sil[3]));
            float qd[8], ki[8];
#pragma unroll
            for (int j = 0; j < 4; ++j) {
                const unsigned qw = qv[j], kw = kv[j];
                const float bl = (2 * j < 4) ? ba[2 * j] : bb[2 * j - 4], bh = (2 * j + 1 < 4) ? ba[2 * j + 1] : bb[2 * j + 1 - 4];
                qd[2 * j] = bflo(qw) * 0.125f * fexp2(bl); qd[2 * j + 1] = bfhi(qw) * 0.125f * fexp2(bh);
                ki[2 * j] = bflo(kw) * fexp2(-bl);         ki[2 * j + 1] = bfhi(kw) * fexp2(-bh);
            }
            *(LAS bf16x8*)(bl_ + G_QD + si * GP + sc8 * 2) = pack8(qd[0], qd[1], qd[2], qd[3], qd[4], qd[5], qd[6], qd[7]);
            *(LAS bf16x8*)(bl_ + G_KI + si * GP + sc8 * 2) = pack8(ki[0], ki[1], ki[2], ki[3], ki[4], ki[5], ki[6], ki[7]);
            *(LAS u32x4*)(bl_ + G_V + si * GVP + sv16 * 2) = v0; *(LAS u32x4*)(bl_ + G_V + si * GVP + sv16 * 2 + 16) = v1;
            if (si == 63) { LAS float* dp = (LAS float*)(bl_ + G_DEC) + sc8;
#pragma unroll
                for (int j = 0; j < 4; ++j) { dp[j] = fexp2(ba[j]); dp[4 + j] = fexp2(bb[j]); } }
        }
        if (n + 1 < 32) GLA_LOAD(n + 1);
        asm volatile("s_waitcnt lgkmcnt(0)" ::: "memory"); __builtin_amdgcn_s_barrier(); asm volatile("" ::: "memory");
        if (n > 0) GLA_FINAL(n - 1, o_prev, sil_prev);
        bf16x8 vT[2], Sb[2];
#pragma unroll
        for (int s = 0; s < 2; ++s) {
            vT[s] = cat8(gather4(bl_ + G_V, GVP, 32 * s + 4 * g, 16 * w, lane), gather4(bl_ + G_V, GVP, 32 * s + 16 + 4 * g, 16 * w, lane));
            Sb[s] = pack8(S[2 * s][0], S[2 * s][1], S[2 * s][2], S[2 * s][3], S[2 * s + 1][0], S[2 * s + 1][1], S[2 * s + 1][2], S[2 * s + 1][3]);
        }
        f32x4 o[4];
#pragma unroll
        for (int it = 0; it < 4; ++it) {
            const LAS unsigned char* qrow = bl_ + G_QD + (16 * it + c) * GP;
            const bf16x8 qn0 = *(const LAS bf16x8*)(qrow + 16 * g), qn1 = *(const LAS bf16x8*)(qrow + 64 + 16 * g);
            f32x4 P[4];
#pragma unroll
            for (int jt = 0; jt < 4; ++jt) {
                P[jt] = (f32x4){0.f, 0.f, 0.f, 0.f};
                if (jt <= it) {
                    const LAS unsigned char* krow = bl_ + G_KI + (16 * jt + c) * GP;
                    const bf16x8 k0 = *(const LAS bf16x8*)(krow + 16 * g), k1 = *(const LAS bf16x8*)(krow + 64 + 16 * g);
                    P[jt] = __builtin_amdgcn_mfma_f32_16x16x32_bf16(k0, qn0, P[jt], 0, 0, 0);
                    P[jt] = __builtin_amdgcn_mfma_f32_16x16x32_bf16(k1, qn1, P[jt], 0, 0, 0);
                    if (jt == it) {
#pragma unroll
                        for (int r = 0; r < 4; ++r) if (4 * g + r > c) P[jt][r] = 0.f;
                        if (it == 0 && n == 0 && lane == 0) P[jt][0] = s00;
                    }
                }
            }
            f32x4 acc = {0.f, 0.f, 0.f, 0.f};
            { const bf16x8 pb = pack8(P[0][0], P[0][1], P[0][2], P[0][3], P[1][0], P[1][1], P[1][2], P[1][3]);
              acc = __builtin_amdgcn_mfma_f32_16x16x32_bf16(vT[0], pb, acc, 0, 0, 0); }
            if (it >= 2) { const bf16x8 pb = pack8(P[2][0], P[2][1], P[2][2], P[2][3], P[3][0], P[3][1], P[3][2], P[3][3]);
              acc = __builtin_amdgcn_mfma_f32_16x16x32_bf16(vT[1], pb, acc, 0, 0, 0); }
#pragma unroll
            for (int s = 0; s < 2; ++s) {
                const s16x4 qa = *(const LAS s16x4*)(qrow + (32 * s + 4 * g) * 2), qb = *(const LAS s16x4*)(qrow + (32 * s + 16 + 4 * g) * 2);
                acc = __builtin_amdgcn_mfma_f32_16x16x32_bf16(Sb[s], cat8(qa, qb), acc, 0, 0, 0);
            }
            o[it] = acc;
        }
#pragma unroll
        for (int dt = 0; dt < 4; ++dt) {
            const f32x4 dec = *(const LAS f32x4*)(bl_ + G_DEC + (16 * dt + 4 * g) * 4);
            f32x4 sacc = S[dt];
#pragma unroll
            for (int s = 0; s < 2; ++s) {
                const bf16x8 ka = cat8(gather4(bl_ + G_KI, GP, 32 * s + 4 * g, 16 * dt, lane), gather4(bl_ + G_KI, GP, 32 * s + 16 + 4 * g, 16 * dt, lane));
                sacc = __builtin_amdgcn_mfma_f32_16x16x32_bf16(ka, vT[s], sacc, 0, 0, 0);
            }
            S[dt] = sacc * dec;
        }
        { LAS float* sq = (LAS float*)(lds + G_SSQ + (n & 1) * 2048);
#pragma unroll
          for (int it = 0; it < 4; ++it) {
            float s = (o[it][0] * o[it][0] + o[it][1] * o[it][1]) + (o[it][2] * o[it][2] + o[it][3] * o[it][3]);
            s += __shfl_xor(s, 16); s += __shfl_xor(s, 32);
            if (g == 0) sq[w * 64 + 16 * it + c] = s;
            o_prev[it] = o[it]; sil_prev[it] = sil[it];
          } }
    }
    asm volatile("s_waitcnt lgkmcnt(0)" ::: "memory"); __builtin_amdgcn_s_barrier(); asm volatile("" ::: "memory");
    GLA_FINAL(31, o_prev, sil_prev);
#undef GLA_LOAD
#undef GLA_FINAL
    __syncthreads();
}

DI void phase_mix(const Args& a, LAS unsigned char* lds, int cidx = 0, int mode = 0) {
    const int tid = threadIdx.x, lane = tid & 63, w = tid >> 6;
    unsigned* ctr = (unsigned*)(a.ws + WS_CTL) + 64 * cidx;
    volatile LAS unsigned* sh = (volatile LAS unsigned*)(lds + MISC_OFF);
    constexpr int NGLA = NB * 4, NSB = NB * 8 * 8, NUNIT = NGLA + NSB;
    unsigned nxt = 0;
    if (tid == 0) nxt = atomicAdd(ctr, 1u);
    for (;;) {
        if (tid == 0) sh[0] = nxt;
        __syncthreads();
        const int u = (int)sh[0];
        __syncthreads();
        if (u >= NUNIT) break;
        if (tid == 0) nxt = atomicAdd(ctr, 1u);
        if (u < NGLA) { if (mode != 1) gla_unit(a, u >> 2, u & 3, lds); }
        else if (mode != 2) {
            const int v = u - NGLA, bh = v >> 3, qb = 7 - (v & 7);
            sb_wave((const bf16_t*)(a.ws + WS_PROJ), (bf16_t*)(a.ws + WS_OCAT), a.sb_g, bh >> 3, bh & 7, qb * 256 + 32 * w, lds + w * 8192, lane);
        }
    }
}

DI void phase_fix(const Args& a) {
    const float* hh = (const float*)(a.ws + WS_HHEAD); const float* ht = (const float*)(a.ws + WS_HTAIL); bf16_t* g = (bf16_t*)(a.ws + WS_G);
    constexpr int PER = 2 * 704;
    for (int it = blockIdx.x * 512 + threadIdx.x; it < 256 * PER; it += gridDim.x * 512) {
        const int pm = it / PER, rem = it % PER, rr = rem / 704, ch = (rem % 704) * 4;
        if ((pm & 7) == 0) continue;
        const int j = ch >> 7, wv = ch & 127, pa = 256 * j + wv, pv = pa + 128;
        const float* t0 = ht + ((size_t)(pm - 1) * 2) * NU; const float* t1 = t0 + NU; const float* h0 = hh + ((size_t)pm * 2) * NU; const float* h1 = h0 + NU;
        const float *m2 = rr == 0 ? t0 : t1, *m1 = rr == 0 ? t1 : h0, *m0 = rr == 0 ? h0 : h1;
        const f32x4 a2 = *(const f32x4*)(m2 + pa), a1 = *(const f32x4*)(m1 + pa), a0 = *(const f32x4*)(m0 + pa);
        const f32x4 v2 = *(const f32x4*)(m2 + pv), v1 = *(const f32x4*)(m1 + pv), v0 = *(const f32x4*)(m0 + pv);
        const f32x4 wa0 = *(const f32x4*)(a.conv_w + ch), wa1 = *(const f32x4*)(a.conv_w + NU + ch), wa2 = *(const f32x4*)(a.conv_w + 2 * NU + ch), ba = *(const f32x4*)(a.conv_b + ch);
        const f32x4 wv0 = *(const f32x4*)(a.conv_w + DFF + ch), wv1 = *(const f32x4*)(a.conv_w + NU + DFF + ch), wv2 = *(const f32x4*)(a.conv_w + 2 * NU + DFF + ch), bv = *(const f32x4*)(a.conv_b + DFF + ch);
        const f32x4 av = ba + wa0 * a2 + wa1 * a1 + wa2 * a0, vv = bv + wv0 * v2 + wv1 * v1 + wv2 * v0;
        float o[4];
#pragma unroll
        for (int c = 0; c < 4; ++c) o[c] = av[c] * vv[c] * __builtin_amdgcn_rcpf(1.f + fexp2(-av[c] * LOG2E));
        u32x2 w; w.x = cvt_pk_bf16(o[0], o[1]); w.y = cvt_pk_bf16(o[2], o[3]);
        *(u32x2*)(g + (size_t)(pm * 256 + rr) * DFF + ch) = w;
    }
}

DI void phase_final(const Args& a) {
    const int lane = threadIdx.x & 63, gw = blockIdx.x * 8 + (threadIdx.x >> 6), NGW = gridDim.x * 8;
    const float* ssq3 = (const float*)(a.ws + WS_SSQ3);
    f32x4 gv[4];
#pragma unroll
    for (int j = 0; j < 4; ++j) gv[j] = ((const f32x4*)a.final_g)[lane + 64 * j];
    for (int m = gw; m < T; m += NGW) {
        const float rs = 1.0f / sqrtf(ssq3[m] * (1.0f / D) + EPS);
        f32x4* xr = (f32x4*)(a.out + (size_t)m * D) + lane;
#pragma unroll
        for (int j = 0; j < 4; ++j) { const f32x4 v = xr[64 * j]; xr[64 * j] = v * rs * gv[j]; }
    }
}

__global__ void __launch_bounds__(512, 2) fwd(Args a) {
    extern __shared__ __attribute__((aligned(16))) unsigned char smem[];
    LAS unsigned char* lds = (LAS unsigned char*)smem;
    const int lo = a.ph_lo, hi = a.ph_hi;
    const int G = gridDim.x; int cu = blockIdx.x;
#ifndef PH_MASK
#define PH_MASK 255
#endif
#define IN(k) (((PH_MASK >> (k)) & 1) && lo <= (k) && (k) < hi)
    volatile LAS unsigned* MISC = (volatile LAS unsigned*)(lds + MISC_OFF);
    if (threadIdx.x < 16) MISC[threadIdx.x] = 0u;
    __syncthreads();
    XcdBarrier xbar; xbar.bar = (unsigned*)(a.ws + WS_CTL) + 24576; xbar.x = 0; xbar.st = nullptr;
    if (a.coop) xbar = xcd_barrier_post((unsigned*)(a.ws + WS_CTL) + 24576, MISC + 8);
    if (a.pad == 0x7eadbeef) cg::this_grid().sync();
#define SEAM(k) do { if (a.coop && IN(k) && IN((k) + 1)) { xcd_barrier(xbar); } } while (0)
    if (IN(0)) { phase_prep(a, lds);
#ifdef PROBE_P0
        cg::this_grid().sync(); phase_prep(a, lds);
#endif
#ifdef PROBE_SYNC4
#endif
    }
    SEAM(0);
    if (a.coop && IN(0) && IN(1) && G == 256 && MISC[11] == 1u) cu = (int)MISC[10] * 8 + (int)xbar.x;
#ifdef CODE_PAD
    asm volatile(".rept " CODE_PAD_STR "\n\ts_nop 0\n\t.endr" ::: "memory");
#endif
#ifdef PROBE_SYNC4
    xcd_barrier(xbar); xcd_barrier(xbar); xcd_barrier(xbar); xcd_barrier(xbar);
#endif
    if (IN(1)) {
        pg8::Gemm g{(const bf16_t*)(a.ws + WS_XB), (const bf16_t*)(a.ws + WS_WIN), T, N1, D}; pg8::StaticOrder S; S.init(T, N1, G, cu);
        Epi1 E{(bf16_t*)(a.ws + WS_PROJ), (float*)(a.ws + WS_B2), (const float*)(a.ws + WS_RSTD1), a.b_gate_up, a.gla_g};
        pg8::gemm_phase<Epi1, pg8::StaticOrder>(lds, g, S, E);
#ifdef PROBE_G1
        cg::this_grid().sync(); pg8::gemm_phase<Epi1, pg8::StaticOrder>(lds, g, S, E);
#endif
    }
    SEAM(1);
    if (IN(2)) { phase_mix(a, lds);
#ifdef PROBE_MIX2
        cg::this_grid().sync(); phase_mix(a, lds, 1, PROBE_MIX2);
#endif
    }
    SEAM(2);
    if (IN(3)) {
        pg8::Gemm g{(const bf16_t*)(a.ws + WS_OCAT), (const bf16_t*)(a.ws + WS_WOUT), T, D, D}; pg8::StaticOrder S; S.init(T, D, G, cu);
        EpiRes<true> E{a.x, ((G == 256) && a.coop) ? nullptr : a.out, (bf16_t*)(a.ws + WS_XB), (float*)(a.ws + WS_SSQ2), ((G == 256) && a.coop) ? (const bf16_t*)(a.ws + WS_XB) : nullptr};
        pg8::gemm_phase<EpiRes<true>, pg8::StaticOrder>(lds, g, S, E);
    }
    SEAM(3);
    if (IN(4)) {
        pg8::Gemm g{(const bf16_t*)(a.ws + WS_XB), (const bf16_t*)(a.ws + WS_WUP), T, NU, D}; pg8::StaticOrder S; S.init(T, NU, G, cu);
        Epi3 E{(bf16_t*)(a.ws + WS_G), (const float*)(a.ws + WS_SSQ2), a.conv_w, a.conv_b, (float*)(a.ws + WS_HHEAD), (float*)(a.ws + WS_HTAIL), (LAS float*)(lds + HALO_OFF), lds + PF_OFF};
        pg8::gemm_phase<Epi3, pg8::StaticOrder>(lds, g, S, E);
#ifdef PROBE_G3
        cg::this_grid().sync(); pg8::gemm_phase<Epi3, pg8::StaticOrder>(lds, g, S, E);
#endif
    }
    SEAM(4);
    if (IN(5)) { phase_fix(a); }
    SEAM(5);
    const bool fused_final = (G == 256) && a.coop;
    if (IN(6)) {
        pg8::Gemm g{(const bf16_t*)(a.ws + WS_G), (const bf16_t*)(a.ws + WS_WDN), T, D, DFF}; pg8::StaticOrder S; S.init(T, D, G, cu);
        if (fused_final) {
            Epi4F E{a.out, (const bf16_t*)(a.ws + WS_XB), a.out, a.final_g, (float*)(a.ws + WS_XCH), (unsigned*)(a.ws + WS_CTL) + 4096, (LAS float*)(lds + HALO_OFF)};
            pg8::gemm_phase<Epi4F, pg8::StaticOrder>(lds, g, S, E);
        } else {
            EpiRes<false> E{a.out, a.out, nullptr, (float*)(a.ws + WS_SSQ3), nullptr};
            pg8::gemm_phase<EpiRes<false>, pg8::StaticOrder>(lds, g, S, E);
        }
    }
    if (!fused_final) {
        SEAM(6);
        if (IN(7)) { phase_final(a); }
    }
#undef IN
#undef SEAM
}

#ifndef ONE_LAUNCH
#define ONE_LAUNCH 1
#endif
extern "C" void kernel_launch(void* const* d_in, const int* in_sizes, int n_in, void* d_out, int out_size, void* d_ws, size_t ws_size, hipStream_t stream) {
    static int grid = 0;
    if (grid == 0) {
        if (n_in != 14 || ws_size < WS_END) { fprintf(stderr, "kernel_launch: unexpected inputs (n_in %d, ws %zu)\n", n_in, ws_size); grid = -1; return; }
        int dev = 0, cus = 0, per_cu = 0;
        hipGetDevice(&dev); hipDeviceGetAttribute(&cus, hipDeviceAttributeMultiprocessorCount, dev);
        if (hipFuncSetAttribute((const void*)fwd, hipFuncAttributeMaxDynamicSharedMemorySize, LDS_BYTES) != hipSuccess) { fprintf(stderr, "kernel_launch: hipFuncSetAttribute failed\n"); grid = -1; return; }
        hipOccupancyMaxActiveBlocksPerMultiprocessor(&per_cu, (const void*)fwd, 512, LDS_BYTES);
        (void)hipGetLastError();
        if (per_cu < 1) per_cu = 1;
        grid = cus * per_cu;
        if (grid != 256) fprintf(stderr, "kernel_launch: note: grid %d (cus %d x %d)\n", grid, cus, per_cu);
    }
    if (grid < 0) return;
    hipMemsetAsync((char*)d_ws + WS_CTL, 0, 768 * 1024, stream);
    Args a{};
    a.x = (const float*)d_in[0]; a.attn_g = (const float*)d_in[1]; a.w_in = (const float*)d_in[2]; a.w_gate_up = (const float*)d_in[3]; a.b_gate_up = (const float*)d_in[4];
    a.sb_g = (const float*)d_in[5]; a.gla_g = (const float*)d_in[6]; a.w_out = (const float*)d_in[7]; a.ffn_g = (const float*)d_in[8]; a.w_up = (const float*)d_in[9];
    a.conv_w = (const float*)d_in[10]; a.conv_b = (const float*)d_in[11]; a.w_down = (const float*)d_in[12]; a.final_g = (const float*)d_in[13];
    a.out = (float*)d_out; a.ws = (unsigned char*)d_ws;
#if ONE_LAUNCH
    a.ph_lo = 0; a.ph_hi = 8; a.coop = 1;
    void* args[] = {&a};
    hipError_t e = hipLaunchCooperativeKernel((const void*)fwd, dim3(grid), dim3(512), args, LDS_BYTES, stream);
    if (e != hipSuccess) fprintf(stderr, "cooperative launch failed: %s (grid %d)\n", hipGetErrorString(e), grid);
#else
    for (int p = 0; p < 8; ++p) { a.ph_lo = p; a.ph_hi = p + 1; a.coop = 0; hipLaunchKernelGGL(fwd, dim3(grid), dim3(512), LDS_BYTES, stream, a); }
#endif
}
```

```cpp
#include <hip/hip_runtime.h>
#include <hip/hip_cooperative_groups.h>
#include <cstdio>
#include <cstdint>
namespace cg = cooperative_groups;

#define DI __device__ __forceinline__
#define LAS __attribute__((address_space(3)))
typedef unsigned short bf16_t;
typedef short bf16x8 __attribute__((ext_vector_type(8)));
typedef short s16x4 __attribute__((ext_vector_type(4)));
typedef float f32x4 __attribute__((ext_vector_type(4)));
typedef float f32x2 __attribute__((ext_vector_type(2)));
typedef float f32x16 __attribute__((ext_vector_type(16)));
typedef unsigned u32x4 __attribute__((ext_vector_type(4)));
typedef unsigned u32x2 __attribute__((ext_vector_type(2)));
typedef __bf16 bf16x2_t __attribute__((ext_vector_type(2)));

constexpr int T = 65536, SEQ = 2048, NB = 32, D = 1024;
constexpr int PP = 3072;
constexpr int Q_OFF = 0, K_OFF = 512, V_OFF = 1024, GQ_OFF = 1536, GK_OFF = 1792, GV_OFF = 2048, OG_OFF = 2560;
constexpr int N1 = 3328;
constexpr int DFF = 2816, NU = 5632;
constexpr float EPS = 1e-6f;
constexpr float LOG2E = 1.4426950408889634f;
constexpr float QSCALE = 0.125f * LOG2E;

constexpr size_t MiB = 1u << 20;
constexpr size_t WS_CTL = 0;
constexpr size_t WS_SSQ2 = 256 * 1024, WS_SSQ3 = 512 * 1024, WS_RSTD1 = 768 * 1024;
constexpr size_t WS_QK0 = 1 * MiB;
constexpr size_t WS_WIN = 2 * MiB, WS_WOUT = 9 * MiB, WS_WUP = 11 * MiB, WS_WDN = 22 * MiB;
constexpr size_t WS_HHEAD = 28 * MiB, WS_HTAIL = 39 * MiB;
constexpr size_t WS_XCH = 50 * MiB;
constexpr size_t WS_XB = 64 * MiB;
constexpr size_t WS_PROJ = 192 * MiB;
constexpr size_t WS_B2 = 576 * MiB;
constexpr size_t WS_OCAT = 640 * MiB;
constexpr size_t WS_G = 192 * MiB;
constexpr size_t WS_END = 768 * MiB;

constexpr int GEMM_LDS = 131072;
constexpr int HALO_OFF = GEMM_LDS;
constexpr int MISC_OFF = HALO_OFF + 10240;
constexpr int PF_OFF = MISC_OFF + 64;
constexpr int LDS_BYTES = 152576;

DI unsigned cvt_pk_bf16(float lo, float hi) { f32x2 v = {lo, hi}; bf16x2_t b = __builtin_convertvector(v, bf16x2_t); return __builtin_bit_cast(unsigned, b); }
DI float bf2f(unsigned short v) { return __uint_as_float(((unsigned)v) << 16); }
DI float bflo(unsigned w) { return __uint_as_float(w << 16); }
DI float bfhi(unsigned w) { return __uint_as_float(w & 0xffff0000u); }
DI float fexp2(float x) { return __builtin_amdgcn_exp2f(x); }
DI float flog2(float x) { return __builtin_amdgcn_logf(x); }
DI float wave_sum(float v) {
#pragma unroll
    for (int o = 1; o < 64; o <<= 1) v += __shfl_xor(v, o);
    return v;
}
template <int CTRL, bool BC> DI float dppf(float old, float src) {
    return __int_as_float(__builtin_amdgcn_update_dpp(__float_as_int(old), __float_as_int(src), CTRL, 0xf, 0xf, BC));
}

namespace pg8 {
constexpr int BM = 256, BK = 64, HALF = 128, HTB = HALF * BK * 2, STAGE_BYTES = 8 * HTB, NXCD = 8, WGM = 8;
DI int lds_byte(int r, int c) { const int st = (r >> 4) * 2 + (c >> 5), rr = r & 15, cc = c & 31, ob = rr * 64 + cc * 2; return st * 1024 + (ob ^ (((ob >> 9) & 1) << 5)); }
DI void stage_rc(int b, int& R, int& C) { const int st = b / 1024, sb = b % 1024, swz = sb ^ (((sb >> 9) & 1) << 5); R = (st >> 1) * 16 + swz / 64; C = (st & 1) * 32 + (swz % 64) / 2; }
DI int perm32(int rho) { const int n = rho >> 4, i = rho & 15; return 8 * (i >> 2) + 4 * n + (i & 3); }
struct Unit { int pm, pn; };
struct Gemm { const bf16_t* A; const bf16_t* Bt; int M, N, K; };
struct StaticOrder {
    int nM, nN, nwg, G, c, rev;
    DI void init(int M, int N, int G_, int c_, int rev_ = 0) { nM = M / BM; nN = N / BM; nwg = nM * nN; G = G_; c = c_; rev = (rev_ && nwg % G_ == 0) ? nwg / G_ : 0; }
    DI bool next(int i, Unit& u) const {
        if (rev) { if (i >= rev) return false; i = rev - 1 - i; }
        const long L = (long)i * G + c; if (L >= nwg) return false;
        int wgid = (int)L; { const int q = nwg / NXCD, r = nwg % NXCD, xcd = wgid % NXCD, off = wgid / NXCD; wgid = (xcd < r ? xcd * (q + 1) : r * (q + 1) + (xcd - r) * q) + off; }
        const int nig = WGM * nN, gid = wgid / nig, fm = gid * WGM, gsz = (nM - fm) < WGM ? (nM - fm) : WGM;
        u.pm = fm + ((wgid % nig) % gsz); u.pn = (wgid % nig) / gsz; return true;
    }
};

template <class Epi, class Sched, bool ALIGN_EPI = true, bool SP2 = true>
DI void gemm_phase(LAS unsigned char* lds, const Gemm g, const Sched& S, const Epi& E) {
    const int tid = threadIdx.x, wid = __builtin_amdgcn_readfirstlane(tid >> 6), lane = tid & 63, wr = wid >> 2, wc = wid & 3, fr = lane & 15, fq = lane >> 4;
    const int K = g.K, nt = K / BK;
    unsigned voffA[2], voffB[2];
#pragma unroll
    for (int i = 0; i < 2; ++i) { int R, C; stage_rc(tid * 16 + i * 8192, R, C); const int Rb = Epi::PERM ? ((R & ~31) + perm32(R & 31)) : R;
        const int Ra = Epi::APERM ? ((R & ~63) + 4 * (R & 15) + ((R >> 4) & 3)) : R;
        voffA[i] = (unsigned)(Ra * K + C) * 2u; voffB[i] = (unsigned)(Rb * K + C) * 2u; }
    const size_t kstep = (size_t)(BK * 2);
    const size_t hstep = (size_t)HALF * K * 2;
    const size_t tstep = 2 * hstep;
    const unsigned ldsw = (unsigned)wid * 1024u;
    const int aoff = lds_byte(wr * 64 + fr, fq * 8), boff = lds_byte(wc * 32 + fr, fq * 8);
#define PG8_SA(b, h) (((b) * 2 + (h)) * HTB)
#define PG8_SB(b, h) ((4 + (b) * 2 + (h)) * HTB)
#define PG8_STAGE(bufoff, gbase, voff) do { _Pragma("unroll") for (int _i = 0; _i < 2; ++_i) \
        __builtin_amdgcn_global_load_lds((const unsigned*)((const char*)(gbase) + (voff)[_i]), (LAS unsigned*)(lds + (bufoff) + ldsw + _i * 8192), 16, 0, 0); } while (0)
#define PG8_LDA(dst, b, h) do { _Pragma("unroll") for (int m = 0; m < 4; ++m) _Pragma("unroll") for (int k = 0; k < 2; ++k) dst[m][k] = *(const LAS bf16x8*)(lds + PG8_SA(b, h) + aoff + m * 2048 + k * 1024); } while (0)
#define PG8_LDB(dst, b, h) do { _Pragma("unroll") for (int n = 0; n < 2; ++n) _Pragma("unroll") for (int k = 0; k < 2; ++k) dst[n][k] = *(const LAS bf16x8*)(lds + PG8_SB(b, h) + boff + n * 2048 + k * 1024); } while (0)
#define PG8_MMA(ai, bj, At, Bt) do { __builtin_amdgcn_s_setprio(1); _Pragma("unroll") for (int m = 0; m < 4; ++m) _Pragma("unroll") for (int n = 0; n < 2; ++n) _Pragma("unroll") for (int k = 0; k < 2; ++k) \
        acc[ai][bj][m][n] = __builtin_amdgcn_mfma_f32_16x16x32_bf16(Bt[n][k], At[m][k], acc[ai][bj][m][n], 0, 0, 0); __builtin_amdgcn_s_setprio(0); } while (0)
#define PG8_WAIT_V(n) asm volatile("s_waitcnt vmcnt(" #n ")" ::: "memory")
#define PG8_WAIT_L(n) asm volatile("s_waitcnt lgkmcnt(" #n ")" ::: "memory")
#define PG8_BAR __builtin_amdgcn_s_barrier()
#define PG8_SCHED __builtin_amdgcn_sched_barrier(0)
    Unit cur, nxt; int ui = 0;
    if (!S.next(0, cur)) return;
    f32x4 acc[2][2][4][2];
#pragma unroll
    for (int a = 0; a < 2; ++a)
#pragma unroll
        for (int b = 0; b < 2; ++b)
#pragma unroll
            for (int m = 0; m < 4; ++m)
#pragma unroll
                for (int n = 0; n < 2; ++n) acc[a][b][m][n] = (f32x4){0.f, 0.f, 0.f, 0.f};
    bf16x8 At[4][2], B0[2][2], B1[2][2];
    const char* cA = (const char*)g.A + (size_t)cur.pm * tstep; const char* cB = (const char*)g.Bt + (size_t)cur.pn * tstep;
    if constexpr (Epi::PF) { E.prefetch(cur, 0, wid, lane); PG8_WAIT_V(0); PG8_BAR; }
    if constexpr (SP2) {
        PG8_STAGE(PG8_SB(0, 0), cB, voffB); PG8_STAGE(PG8_SB(0, 1), cB + hstep, voffB); PG8_STAGE(PG8_SA(0, 0), cA, voffA); PG8_STAGE(PG8_SA(0, 1), cA + hstep, voffA);
        if (wr == 1) PG8_BAR;
        PG8_WAIT_V(2); PG8_BAR;
        PG8_STAGE(PG8_SB(1, 0), cB + kstep, voffB); PG8_STAGE(PG8_SA(1, 0), cA + kstep, voffA); PG8_STAGE(PG8_SB(1, 1), cB + hstep + kstep, voffB);
        PG8_WAIT_V(6); PG8_BAR;
    } else {
        PG8_STAGE(PG8_SB(0, 0), cB, voffB); PG8_STAGE(PG8_SA(0, 0), cA, voffA); PG8_STAGE(PG8_SB(0, 1), cB + hstep, voffB); PG8_STAGE(PG8_SA(0, 1), cA + hstep, voffA);
        if (wr == 1) PG8_BAR;
        PG8_WAIT_V(4); PG8_BAR;
        PG8_STAGE(PG8_SB(1, 0), cB + kstep, voffB); PG8_STAGE(PG8_SA(1, 0), cA + kstep, voffA); PG8_STAGE(PG8_SB(1, 1), cB + hstep + kstep, voffB);
        PG8_WAIT_V(6); PG8_BAR;
    }
    for (;;) {
        const bool has_next = S.next(ui + 1, nxt);
        const char* nA = has_next ? (const char*)g.A + (size_t)nxt.pm * tstep : cA; const char* nB = has_next ? (const char*)g.Bt + (size_t)nxt.pn * tstep : cB;
        for (int t = 0; t < nt; t += 2) {
            const bool last = (t == nt - 2);
            const char* a1 = cA + (size_t)(t + 1) * kstep;
            const char* a2 = last ? nA : cA + (size_t)(t + 2) * kstep; const char* b2 = last ? nB : cB + (size_t)(t + 2) * kstep;
            const char* a3 = a2 + kstep; const char* b3 = b2 + kstep;
            if constexpr (SP2) {
            PG8_LDB(B0, 0, 0); PG8_LDB(B1, 0, 1); PG8_SCHED; PG8_LDA(At, 0, 0); PG8_STAGE(PG8_SA(1, 1), a1 + hstep, voffA);
            PG8_WAIT_V(8); PG8_WAIT_L(0); PG8_BAR; PG8_MMA(0, 0, At, B0); PG8_MMA(0, 1, At, B1); PG8_BAR; PG8_SCHED;
            PG8_LDA(At, 0, 1); PG8_STAGE(PG8_SB(0, 0), b2, voffB); PG8_STAGE(PG8_SB(0, 1), b2 + hstep, voffB); PG8_STAGE(PG8_SA(0, 0), a2, voffA);
            PG8_WAIT_V(8); PG8_WAIT_L(0); PG8_BAR; PG8_MMA(1, 0, At, B0); PG8_MMA(1, 1, At, B1); PG8_BAR; PG8_SCHED;
            PG8_LDB(B0, 1, 0); PG8_LDB(B1, 1, 1); PG8_SCHED; PG8_LDA(At, 1, 0); PG8_STAGE(PG8_SA(0, 1), a2 + hstep, voffA);
            PG8_WAIT_V(8); PG8_WAIT_L(0); PG8_BAR; PG8_MMA(0, 0, At, B0); PG8_MMA(0, 1, At, B1); PG8_BAR; PG8_SCHED;
            PG8_LDA(At, 1, 1); PG8_STAGE(PG8_SB(1, 0), b3, voffB); PG8_STAGE(PG8_SB(1, 1), b3 + hstep, voffB); PG8_STAGE(PG8_SA(1, 0), a3, voffA);
            PG8_WAIT_V(8); PG8_WAIT_L(0); PG8_BAR; PG8_MMA(1, 0, At, B0); PG8_MMA(1, 1, At, B1); PG8_BAR; PG8_SCHED;
            } else {
            PG8_LDB(B0, 0, 0); PG8_SCHED; PG8_LDA(At, 0, 0); PG8_STAGE(PG8_SA(1, 1), a1 + hstep, voffA);
            PG8_WAIT_L(8); PG8_BAR; PG8_WAIT_L(0); PG8_MMA(0, 0, At, B0); PG8_BAR; PG8_SCHED;
            PG8_LDB(B1, 0, 1); PG8_STAGE(PG8_SB(0, 0), b2, voffB);
            PG8_BAR; PG8_WAIT_L(0); PG8_MMA(0, 1, At, B1); PG8_BAR;
            PG8_LDA(At, 0, 1); PG8_STAGE(PG8_SA(0, 0), a2, voffA);
            PG8_BAR; PG8_WAIT_L(0); PG8_MMA(1, 0, At, B0); PG8_BAR; PG8_SCHED;
            PG8_STAGE(PG8_SB(0, 1), b2 + hstep, voffB);
            PG8_WAIT_V(6); PG8_BAR; PG8_MMA(1, 1, At, B1); PG8_BAR;
            PG8_LDB(B0, 1, 0); PG8_SCHED; PG8_LDA(At, 1, 0); PG8_STAGE(PG8_SA(0, 1), a2 + hstep, voffA);
            PG8_WAIT_L(8); PG8_BAR; PG8_WAIT_L(0); PG8_MMA(0, 0, At, B0); PG8_BAR; PG8_SCHED;
            PG8_LDB(B1, 1, 1); PG8_STAGE(PG8_SB(1, 0), b3, voffB);
            PG8_BAR; PG8_WAIT_L(0); PG8_MMA(0, 1, At, B1); PG8_BAR;
            PG8_LDA(At, 1, 1); PG8_STAGE(PG8_SA(1, 0), a3, voffA);
            PG8_BAR; PG8_WAIT_L(0); PG8_MMA(1, 0, At, B0); PG8_BAR; PG8_SCHED;
            PG8_STAGE(PG8_SB(1, 1), b3 + hstep, voffB);
            PG8_WAIT_V(6); PG8_BAR; PG8_MMA(1, 1, At, B1); PG8_BAR;
            }
        }
        if constexpr (ALIGN_EPI) { if (wr == 0) PG8_BAR; }
        if constexpr (Epi::PF) E(acc, cur, wr, wc, fr, fq, ui, has_next, nxt, wid, lane); else E(acc, cur, wr, wc, fr, fq);
        if (!has_next) break;
#pragma unroll
        for (int a = 0; a < 2; ++a)
#pragma unroll
            for (int b = 0; b < 2; ++b)
#pragma unroll
                for (int m = 0; m < 4; ++m)
#pragma unroll
                    for (int n = 0; n < 2; ++n) acc[a][b][m][n] = (f32x4){0.f, 0.f, 0.f, 0.f};
        cur = nxt; cA = nA; cB = nB; ++ui;
        if constexpr (ALIGN_EPI) { if (wr == 1) PG8_BAR; }
    }
    PG8_WAIT_V(0);
    if constexpr (!ALIGN_EPI) { if (wr == 0) PG8_BAR; }
    PG8_BAR;
#undef PG8_SA
#undef PG8_SB
#undef PG8_STAGE
#undef PG8_LDA
#undef PG8_LDB
#undef PG8_MMA
#undef PG8_WAIT_V
#undef PG8_WAIT_L
#undef PG8_BAR
#undef PG8_SCHED
}
}
using pg8::Unit;
typedef f32x4 Acc[2][2][4][2];

struct Epi1 {
    static constexpr bool PERM = true, PF = false, APERM = false;
    bf16_t* proj; float* b2; const float* rstd; const float* bgate; const float* glag;
    DI void operator()(Acc& acc, const Unit& u, int wr, int wc, int fr, int fq) const {
        const int row0 = u.pm * 256 + wr * 64 + fr;
        if (u.pn < 12) {
            const int col0 = u.pn * 256 + wc * 32 + 8 * fq;
            const bool isog = u.pn >= 10;
            f32x4 gg[2][2];
#pragma unroll
            for (int bj = 0; bj < 2; ++bj) { gg[bj][0] = isog ? *(const f32x4*)(glag + col0 - OG_OFF + bj * 128) : (f32x4){1.f, 1.f, 1.f, 1.f}; gg[bj][1] = isog ? *(const f32x4*)(glag + col0 - OG_OFF + bj * 128 + 4) : (f32x4){1.f, 1.f, 1.f, 1.f}; }
#pragma unroll
            for (int ai = 0; ai < 2; ++ai)
#pragma unroll
                for (int m = 0; m < 4; ++m) {
                    const int row = row0 + ai * 128 + m * 16; const float sc = rstd[row];
                    bf16_t* rowp = proj + (size_t)row * PP + col0;
#pragma unroll
                    for (int bj = 0; bj < 2; ++bj) { f32x4 v0 = acc[ai][bj][m][0] * sc, v1 = acc[ai][bj][m][1] * sc;
                        if (isog) {
#pragma unroll
                            for (int c = 0; c < 4; ++c) { v0[c] = v0[c] * __builtin_amdgcn_rcpf(1.f + fexp2(-v0[c] * LOG2E)) * gg[bj][0][c]; v1[c] = v1[c] * __builtin_amdgcn_rcpf(1.f + fexp2(-v1[c] * LOG2E)) * gg[bj][1][c]; }
                        }
                        u32x4 w; w.x = cvt_pk_bf16(v0[0], v0[1]); w.y = cvt_pk_bf16(v0[2], v0[3]); w.z = cvt_pk_bf16(v1[0], v1[1]); w.w = cvt_pk_bf16(v1[2], v1[3]);
                        *(u32x4*)(rowp + bj * 128) = w; }
                }
        } else {
            const int c0 = wc * 32 + 8 * fq;
            const int lane = threadIdx.x & 63;
#pragma unroll
            for (int ai = 0; ai < 2; ++ai) {
                float sc[4];
#pragma unroll
                for (int m = 0; m < 4; ++m) sc[m] = rstd[row0 + ai * 128 + m * 16];
#pragma unroll
                for (int bj = 0; bj < 2; ++bj)
#pragma unroll
                    for (int n = 0; n < 2; ++n) {
                        const int cc = c0 + 128 * bj + 4 * n;
                        const f32x4 bias = *(const f32x4*)(bgate + cc);
                        f32x4 carry = {0.f, 0.f, 0.f, 0.f};
#pragma unroll
                        for (int m = 0; m < 4; ++m) {
                            const f32x4 v = acc[ai][bj][m][n] * sc[m] + bias;
                            f32x4 la;
#pragma unroll
                            for (int c = 0; c < 4; ++c) {
                                const float x = v[c];
                                float l = fminf(x, 0.f) * LOG2E - flog2(1.f + fexp2(-fabsf(x) * LOG2E));
                                l *= (1.0f / 16.0f);
                                l += dppf<0x111, true>(0.f, l);
                                l += dppf<0x112, true>(0.f, l);
                                l += dppf<0x114, true>(0.f, l);
                                l += dppf<0x118, true>(0.f, l);
                                l += carry[c];
                                carry[c] = __shfl(l, (lane & 48) | 15);
                                la[c] = l;
                            }
                            *(f32x4*)(b2 + (size_t)(row0 + ai * 128 + m * 16) * 256 + cc) = la;
                        }
                    }
            }
        }
    }
};

template <bool WB> struct EpiRes {
    static constexpr bool PERM = true, PF = false, APERM = false;
    const float* base; float* out; bf16_t* outb; float* ssq; const bf16_t* baseb;
    DI void operator()(Acc& acc, const Unit& u, int wr, int wc, int fr, int fq) const {
        const int row0 = u.pm * 256 + wr * 64 + fr, col0 = u.pn * 256 + wc * 32 + 8 * fq;
#pragma unroll
        for (int ai = 0; ai < 2; ++ai)
#pragma unroll
            for (int m = 0; m < 4; ++m) {
                const int row = row0 + ai * 128 + m * 16; const size_t off = (size_t)row * D + col0; float s = 0.f;
#pragma unroll
                for (int bj = 0; bj < 2; ++bj) {
                    f32x4 b0, b1;
                    if (baseb) { const u32x4 rb = *(const u32x4*)(baseb + off + bj * 128); b0 = (f32x4){bflo(rb.x), bfhi(rb.x), bflo(rb.y), bfhi(rb.y)}; b1 = (f32x4){bflo(rb.z), bfhi(rb.z), bflo(rb.w), bfhi(rb.w)}; }
                    else { b0 = *(const f32x4*)(base + off + bj * 128); b1 = *(const f32x4*)(base + off + bj * 128 + 4); }
                    const f32x4 v0 = acc[ai][bj][m][0] + b0, v1 = acc[ai][bj][m][1] + b1;
                    if (out) { *(f32x4*)(out + off + bj * 128) = v0; *(f32x4*)(out + off + bj * 128 + 4) = v1; }
                    s += (v0[0] * v0[0] + v0[1] * v0[1]) + (v0[2] * v0[2] + v0[3] * v0[3]) + (v1[0] * v1[0] + v1[1] * v1[1]) + (v1[2] * v1[2] + v1[3] * v1[3]);
                    if (WB) { u32x4 w; w.x = cvt_pk_bf16(v0[0], v0[1]); w.y = cvt_pk_bf16(v0[2], v0[3]); w.z = cvt_pk_bf16(v1[0], v1[1]); w.w = cvt_pk_bf16(v1[2], v1[3]);
                        *(u32x4*)(outb + off + bj * 128) = w; }
                }
                s += __shfl_xor(s, 16); s += __shfl_xor(s, 32);
                if (fq == 0) atomicAdd(ssq + row, s);
            }
    }
};

DI f32x4 rot_prev(const f32x4& cur, const f32x4& prev, int fr, int which) {
    f32x4 r;
#pragma unroll
    for (int c = 0; c < 4; ++c) {
        if (which == 1) { const float t = dppf<0x10F, true>(0.f, prev[c]); r[c] = dppf<0x111, false>(t, cur[c]); }
        else            { const float t = dppf<0x10E, true>(0.f, prev[c]); r[c] = dppf<0x112, false>(t, cur[c]); }
    }
    return r;
}
struct Epi3 {
    static constexpr bool PERM = true, PF = true, APERM = true;
    bf16_t* g; const float* ssq2; const float* convw; const float* convb; float* hhead; float* htail; LAS float* halo; LAS unsigned char* pf;
    DI void prefetch(const Unit& u, int par, int wid, int lane) const {
        LAS unsigned char* buf = pf + par * 5120;
        if (wid < 4) {
            const int k = 2 * wid + (lane >> 5), chunk = lane & 31, kk = k & 3;
            const float* src = (kk == 3 ? convb : convw + kk * NU) + (k >= 4 ? DFF : 0) + u.pn * 128 + 4 * chunk;
            __builtin_amdgcn_global_load_lds((const unsigned*)src, (LAS unsigned*)(buf + wid * 1024), 16, 0, 0);
        } else if (wid == 4) {
            __builtin_amdgcn_global_load_lds((const unsigned*)(ssq2 + u.pm * 256 + 4 * lane), (LAS unsigned*)(buf + 4096), 16, 0, 0);
        }
    }
    DI void operator()(Acc& acc, const Unit& u, int wr, int wc, int fr, int fq, int ui, bool has_next, const Unit& nxt, int wid, int lane) const {
        const int rowb = u.pm * 256 + wr * 64 + 4 * fr;
        const int cl = wc * 32 + 8 * fq;
        if (has_next) prefetch(nxt, (ui + 1) & 1, wid, lane);
        const LAS unsigned char* cb = pf + (ui & 1) * 5120;
#pragma unroll
        for (int ai = 0; ai < 2; ++ai) {
            const f32x4 sq = *(const LAS f32x4*)(cb + 4096 + (ai * 128 + wr * 64 + 4 * fr) * 4);
#pragma unroll
            for (int m = 0; m < 4; ++m) { const float sc = __builtin_amdgcn_rsqf(sq[m] * (1.0f / D) + EPS);
#pragma unroll
                for (int bj = 0; bj < 2; ++bj) { acc[ai][bj][m][0] *= sc; acc[ai][bj][m][1] *= sc; } } }
        if (fr == 15) {
#pragma unroll
            for (int ai = 0; ai < 2; ++ai)
#pragma unroll
                for (int r = 0; r < 2; ++r) {
                    LAS float* hp = halo + ((2 * ai + wr + 1) * 2 + r) * 256 + cl;
#pragma unroll
                    for (int bj = 0; bj < 2; ++bj) { *(LAS f32x4*)(hp + bj * 128) = acc[ai][bj][2 + r][0]; *(LAS f32x4*)(hp + bj * 128 + 4) = acc[ai][bj][2 + r][1]; }
                }
            if (wr == 0) { const f32x4 z = {0.f, 0.f, 0.f, 0.f};
#pragma unroll
                for (int r = 0; r < 2; ++r) { LAS float* hp = halo + r * 256 + cl; *(LAS f32x4*)(hp) = z; *(LAS f32x4*)(hp + 4) = z; *(LAS f32x4*)(hp + 128) = z; *(LAS f32x4*)(hp + 132) = z; } }
            if (wr == 1) {
#pragma unroll
                for (int r = 0; r < 2; ++r) { float* tp = htail + ((size_t)u.pm * 2 + r) * NU + u.pn * 256 + cl;
#pragma unroll
                    for (int bj = 0; bj < 2; ++bj) { *(f32x4*)(tp + bj * 128) = acc[1][bj][2 + r][0]; *(f32x4*)(tp + bj * 128 + 4) = acc[1][bj][2 + r][1]; } } }
        }
        if (fr == 0 && wr == 0) {
#pragma unroll
            for (int r = 0; r < 2; ++r) { float* tp = hhead + ((size_t)u.pm * 2 + r) * NU + u.pn * 256 + cl;
#pragma unroll
                for (int bj = 0; bj < 2; ++bj) { *(f32x4*)(tp + bj * 128) = acc[0][bj][r][0]; *(f32x4*)(tp + bj * 128 + 4) = acc[0][bj][r][1]; } } }
        asm volatile("s_waitcnt lgkmcnt(0)" ::: "memory"); __builtin_amdgcn_s_barrier(); asm volatile("" ::: "memory");
        const int ch = u.pn * 128 + cl;
#pragma unroll
        for (int n = 0; n < 2; ++n) {
            const LAS unsigned char* cp = cb + (cl + 4 * n) * 4;
            const f32x4 wa0 = *(const LAS f32x4*)(cp), wa1 = *(const LAS f32x4*)(cp + 512), wa2 = *(const LAS f32x4*)(cp + 1024), ba = *(const LAS f32x4*)(cp + 1536);
            const f32x4 wv0 = *(const LAS f32x4*)(cp + 2048), wv1 = *(const LAS f32x4*)(cp + 2560), wv2 = *(const LAS f32x4*)(cp + 3072), bv = *(const LAS f32x4*)(cp + 3584);
#pragma unroll
            for (int ai = 0; ai < 2; ++ai) {
                asm volatile("" ::: "memory"); __builtin_amdgcn_sched_barrier(0);
                f32x4 ha1 = {0.f, 0.f, 0.f, 0.f}, ha2 = ha1, hv1 = ha1, hv2 = ha1;
                if (fr == 0) { const LAS float* hp = halo + ((2 * ai + wr) * 2) * 256 + cl + 4 * n;
                    ha2 = *(const LAS f32x4*)hp; hv2 = *(const LAS f32x4*)(hp + 128); ha1 = *(const LAS f32x4*)(hp + 256); hv1 = *(const LAS f32x4*)(hp + 384); }
                f32x4 pa1, pa2, pv1, pv2;
#pragma unroll
                for (int c = 0; c < 4; ++c) {
                    pa1[c] = dppf<0x111, false>(ha1[c], acc[ai][0][3][n][c]); pa2[c] = dppf<0x111, false>(ha2[c], acc[ai][0][2][n][c]);
                    pv1[c] = dppf<0x111, false>(hv1[c], acc[ai][1][3][n][c]); pv2[c] = dppf<0x111, false>(hv2[c], acc[ai][1][2][n][c]);
                }
                asm volatile("" : "+v"(pa1), "+v"(pa2), "+v"(pv1), "+v"(pv2));
#pragma unroll
                for (int m = 0; m < 4; ++m) {
                    asm volatile("" : "+v"(acc[ai][0][m][n]), "+v"(acc[ai][1][m][n]), "+v"(pa1), "+v"(pv1));
                    const f32x4 ca = acc[ai][0][m][n], cv = acc[ai][1][m][n];
                    const f32x4 a = ba + wa0 * pa2 + wa1 * pa1 + wa2 * ca;
                    const f32x4 v = bv + wv0 * pv2 + wv1 * pv1 + wv2 * cv;
                    f32x4 o;
#pragma unroll
                    for (int c = 0; c < 4; ++c) o[c] = a[c] * v[c] * __builtin_amdgcn_rcpf(1.f + fexp2(-a[c] * LOG2E));
                    acc[ai][0][m][n] = o; pa2 = pa1; pv2 = pv1; pa1 = ca; pv1 = cv;
                    asm volatile("" : "+v"(acc[ai][0][m][n]));
                }
            }
        }
#pragma unroll
        for (int ai = 0; ai < 2; ++ai)
#pragma unroll
            for (int m = 0; m < 4; ++m) { const f32x4 v0 = acc[ai][0][m][0], v1 = acc[ai][0][m][1];
                u32x4 w; w.x = cvt_pk_bf16(v0[0], v0[1]); w.y = cvt_pk_bf16(v0[2], v0[3]); w.z = cvt_pk_bf16(v1[0], v1[1]); w.w = cvt_pk_bf16(v1[2], v1[3]);
                *(u32x4*)(g + (size_t)(rowb + ai * 128 + m) * DFF + ch) = w; }
    }
};

struct Epi4F {
    static constexpr bool PERM = true, PF = false, APERM = false;
    const float* base; const bf16_t* baseb; float* out; const float* gfin; float* xbuf; unsigned* cnt; LAS float* scr;
    DI void operator()(Acc& acc, const Unit& u, int wr, int wc, int fr, int fq) const {
        const int tid = threadIdx.x, lane = tid & 63;
        const int row0 = u.pm * 256 + wr * 64 + fr, col0 = u.pn * 256 + wc * 32 + 8 * fq;
        LAS float* part = scr; LAS float* S = scr + 1024;
#pragma unroll
        for (int ai = 0; ai < 2; ++ai)
#pragma unroll
            for (int m = 0; m < 4; ++m) {
                const size_t off = (size_t)(row0 + ai * 128 + m * 16) * D + col0; float s = 0.f;
#pragma unroll
                for (int bj = 0; bj < 2; ++bj) {
                    f32x4 b0, b1;
                    if (baseb) { const u32x4 rb = *(const u32x4*)(baseb + off + bj * 128); b0 = (f32x4){bflo(rb.x), bfhi(rb.x), bflo(rb.y), bfhi(rb.y)}; b1 = (f32x4){bflo(rb.z), bfhi(rb.z), bflo(rb.w), bfhi(rb.w)}; }
                    else { b0 = *(const f32x4*)(base + off + bj * 128); b1 = *(const f32x4*)(base + off + bj * 128 + 4); }
                    const f32x4 v0 = acc[ai][bj][m][0] + b0, v1 = acc[ai][bj][m][1] + b1;
                    acc[ai][bj][m][0] = v0; acc[ai][bj][m][1] = v1;
                    s += (v0[0] * v0[0] + v0[1] * v0[1]) + (v0[2] * v0[2] + v0[3] * v0[3]) + (v1[0] * v1[0] + v1[1] * v1[1]) + (v1[2] * v1[2] + v1[3] * v1[3]);
                }
                s += __shfl_xor(s, 16); s += __shfl_xor(s, 32);
                if (fq == 0) part[wc * 256 + ai * 128 + wr * 64 + m * 16 + fr] = s;
                if (m & 1) asm volatile("" ::: "memory");
            }
        asm volatile("s_waitcnt lgkmcnt(0)" ::: "memory"); __builtin_amdgcn_s_barrier(); asm volatile("" ::: "memory");
        unsigned* cw = cnt + 64 * u.pm;
        if (tid < 256) {
            const float tot = (part[tid] + part[256 + tid]) + (part[512 + tid] + part[768 + tid]);
            __hip_atomic_store(xbuf + ((size_t)u.pm * 4 + u.pn) * 256 + tid, tot, __ATOMIC_RELAXED, __HIP_MEMORY_SCOPE_AGENT);
            asm volatile("s_waitcnt vmcnt(0)" ::: "memory");
            if (lane == 0) __hip_atomic_fetch_add(cw, 1u, __ATOMIC_RELAXED, __HIP_MEMORY_SCOPE_AGENT);
        }
        if (tid == 0) {
            unsigned spins = 0;
            while (__hip_atomic_load(cw, __ATOMIC_RELAXED, __HIP_MEMORY_SCOPE_AGENT) < 16u) { __builtin_amdgcn_s_sleep(2); if (++spins > (1u << 24)) break; }
            __builtin_amdgcn_fence(__ATOMIC_ACQUIRE, "agent");
        }
        asm volatile("s_waitcnt vmcnt(0) lgkmcnt(0)" ::: "memory"); __builtin_amdgcn_s_barrier(); asm volatile("" ::: "memory");
        if (tid < 256) {
            const float* sl = xbuf + (size_t)u.pm * 4 * 256 + tid;
            const float t = (__hip_atomic_load(sl, __ATOMIC_RELAXED, __HIP_MEMORY_SCOPE_AGENT) + __hip_atomic_load(sl + 256, __ATOMIC_RELAXED, __HIP_MEMORY_SCOPE_AGENT))
                          + (__hip_atomic_load(sl + 512, __ATOMIC_RELAXED, __HIP_MEMORY_SCOPE_AGENT) + __hip_atomic_load(sl + 768, __ATOMIC_RELAXED, __HIP_MEMORY_SCOPE_AGENT));
            S[tid] = 1.0f / sqrtf(t * (1.0f / D) + EPS);
        }
        asm volatile("s_waitcnt lgkmcnt(0)" ::: "memory"); __builtin_amdgcn_s_barrier(); asm volatile("" ::: "memory");
        f32x4 gv[2][2];
#pragma unroll
        for (int bj = 0; bj < 2; ++bj) { gv[bj][0] = *(const f32x4*)(gfin + col0 + bj * 128); gv[bj][1] = *(const f32x4*)(gfin + col0 + bj * 128 + 4); }
#pragma unroll
        for (int ai = 0; ai < 2; ++ai)
#pragma unroll
            for (int m = 0; m < 4; ++m) {
                const float rs = S[ai * 128 + wr * 64 + m * 16 + fr]; const size_t off = (size_t)(row0 + ai * 128 + m * 16) * D + col0;
#pragma unroll
                for (int bj = 0; bj < 2; ++bj) { *(f32x4*)(out + off + bj * 128) = acc[ai][bj][m][0] * rs * gv[bj][0]; *(f32x4*)(out + off + bj * 128 + 4) = acc[ai][bj][m][1] * rs * gv[bj][1]; }
            }
    }
};


#define RLX_AGENT __ATOMIC_RELAXED, __HIP_MEMORY_SCOPE_AGENT
#define XB_TMO      128
#define XB_XCNT(j)  (256  + 64 * (j))
#define XB_XSUB(j)  (1280 + 64 * (j))
#define XB_XGEN(j)  (2304 + 64 * (j))
#define XB_TOP      3328
#define XB_TOPGEN   3392
#define XCD_BAR_WORDS 3456
#define XB_SPIN_CAP (1u << 18)

__device__ __forceinline__ unsigned xb_ld(unsigned* p)              { return __hip_atomic_load(p, __ATOMIC_RELAXED, __HIP_MEMORY_SCOPE_AGENT); }
__device__ __forceinline__ unsigned xb_add(unsigned* p, unsigned v) { return __hip_atomic_fetch_add(p, v, __ATOMIC_RELAXED, __HIP_MEMORY_SCOPE_AGENT); }
__device__ __forceinline__ unsigned xb_xcc_id() { return (unsigned)__builtin_amdgcn_s_getreg((3 << 11) | 20) & 0xFu; }
#define XB_SPIN(cond, bar) do { unsigned _sp = 0; while (cond) { __builtin_amdgcn_s_sleep(1); \
    if ((++_sp & 255u) == 0u) { if (xb_ld(&(bar)[XB_TMO])) break; if (_sp > XB_SPIN_CAP) { atomicAdd(&(bar)[XB_TMO], 1u); break; } } } } while (0)

struct XcdBarrier {
    unsigned* bar; unsigned x;
    volatile LAS unsigned* st;
};

__device__ __forceinline__ XcdBarrier xcd_barrier_post(unsigned* bar, volatile LAS unsigned* st) {
    XcdBarrier b; b.bar = bar; b.x = xb_xcc_id(); b.st = st;
    if (threadIdx.x == 0) (void)xb_add(&bar[XB_XCNT(b.x)], 1u);
    return b;
}
__device__ __forceinline__ void xcd_barrier_complete(unsigned* bar, unsigned x, unsigned& nloc, unsigned& nx) {
    const unsigned G = gridDim.x * gridDim.y * gridDim.z;
    unsigned sum, cnt, mine, sp = 0u;
    for (;;) {
        sum = 0u; cnt = 0u; mine = 0u;
#pragma unroll
        for (unsigned j = 0; j < 16; ++j) { const unsigned c = xb_ld(&bar[XB_XCNT(j)]); sum += c; cnt += (c > 0u) ? 1u : 0u; mine = (j == x) ? c : mine; }
        if (sum == G) break;
        __builtin_amdgcn_s_sleep(1);
        if ((++sp & 255u) == 0u) { if (xb_ld(&bar[XB_TMO])) break; if (sp > XB_SPIN_CAP) { atomicAdd(&bar[XB_TMO], 1u); break; } }
    }
    nloc = mine > 0u ? mine : 1u; nx = cnt > 0u ? cnt : 1u;
}

__device__ __forceinline__ void xcd_barrier(const XcdBarrier& b) {
    asm volatile("s_waitcnt vmcnt(0)" ::: "memory");
    __syncthreads();
    if (threadIdx.x == 0) {
        unsigned* bar = b.bar;
        __builtin_amdgcn_s_waitcnt(0);
        unsigned nloc = b.st[0], nx = b.st[1];
        if (nloc == 0u) { xcd_barrier_complete(bar, b.x, nloc, nx); b.st[0] = nloc; b.st[1] = nx; }
        const unsigned old = xb_add(&bar[XB_XSUB(b.x)], 1u);
        const unsigned gen = old / nloc;
        if (old + 1u == (gen + 1u) * nloc) {
            __builtin_amdgcn_fence(__ATOMIC_RELEASE, "agent");
            asm volatile("s_waitcnt vmcnt(0)" ::: "memory");
            const unsigned og = xb_add(&bar[XB_TOP], 1u);
            const unsigned tg = og / nx;
            if (og + 1u == (tg + 1u) * nx) xb_add(&bar[XB_TOPGEN], 1u);
            else XB_SPIN(xb_ld(&bar[XB_TOPGEN]) == tg, bar);
            __builtin_amdgcn_fence(__ATOMIC_ACQUIRE, "agent");
            xb_add(&bar[XB_XGEN(b.x)], 1u);
            asm volatile("s_waitcnt vmcnt(0)" ::: "memory");
        } else {
            XB_SPIN(xb_ld(&bar[XB_XGEN(b.x)]) == gen, bar);
            __builtin_amdgcn_fence(__ATOMIC_ACQUIRE, "agent");
            asm volatile("s_waitcnt vmcnt(0)" ::: "memory");
        }
    }
    __syncthreads();
}

struct Args {
    const float* x; const float* attn_g; const float* w_in; const float* w_gate_up; const float* b_gate_up; const float* sb_g; const float* gla_g; const float* w_out;
    const float* ffn_g; const float* w_up; const float* conv_w; const float* conv_b; const float* w_down; const float* final_g;
    float* out; unsigned char* ws; int ph_lo, ph_hi, coop, pad;
};

DI void tr_item(const float* src, int ldsrc, const float* gain, float cscale, bf16_t* dst, int lddst, LAS float* scr, int lane) {
    {
        const f32x4* sp = (const f32x4*)(src + (size_t)lane * ldsrc); const float gs = gain ? gain[lane] * cscale : cscale;
        f32x4 v[8];
#pragma unroll
        for (int j = 0; j < 8; ++j) v[j] = sp[j];
#pragma unroll
        for (int j = 0; j < 8; ++j)
#pragma unroll
            for (int e = 0; e < 4; ++e) scr[lane * 33 + 4 * j + e] = v[j][e] * gs;
    }
    asm volatile("s_waitcnt lgkmcnt(0)" ::: "memory");
    const int c = lane & 7;
#pragma unroll
    for (int j = 0; j < 4; ++j) { const int n = (lane >> 3) + 8 * j; const LAS float* s = scr + (8 * c) * 33 + n;
        u32x4 o; o.x = cvt_pk_bf16(s[0 * 33], s[1 * 33]); o.y = cvt_pk_bf16(s[2 * 33], s[3 * 33]); o.z = cvt_pk_bf16(s[4 * 33], s[5 * 33]); o.w = cvt_pk_bf16(s[6 * 33], s[7 * 33]);
        *(u32x4*)(dst + (size_t)n * lddst + 8 * c) = o; }
    asm volatile("s_waitcnt lgkmcnt(0)" ::: "memory");
}
DI void phase_prep(const Args& a, LAS unsigned char* lds) {
    const int tid = threadIdx.x, lane = tid & 63, wave = tid >> 6;
    const int gw = blockIdx.x * 8 + wave, NGW = gridDim.x * 8;
    LAS float* scr = (LAS float*)(lds + wave * 16384);
    bf16_t* Win = (bf16_t*)(a.ws + WS_WIN); bf16_t* Wout = (bf16_t*)(a.ws + WS_WOUT); bf16_t* Wup = (bf16_t*)(a.ws + WS_WUP); bf16_t* Wdn = (bf16_t*)(a.ws + WS_WDN);
    constexpr int I_IN = 16 * 96, I_OUT = 16 * 32, I_UP = 16 * 176, I_DN = 44 * 32, NIT = I_IN + I_OUT + I_UP + I_DN;
    for (int it = gw; it < NIT; it += NGW) {
        int r = it;
        if (r < I_IN) { const int kb = r / 96, nb = r % 96, k0 = 64 * kb, n0 = 32 * nb, c0 = n0 < 2560 ? n0 : n0 + 16;
            tr_item(a.w_in + (size_t)k0 * 3088 + c0, 3088, a.attn_g + k0, n0 < 512 ? QSCALE : 1.0f, Win + (size_t)n0 * D + k0, D, scr, lane); continue; }
        r -= I_IN;
        if (r < I_OUT) { const int kb = r / 32, nb = r % 32, k0 = 64 * kb, n0 = 32 * nb;
            tr_item(a.w_out + (size_t)k0 * D + n0, D, nullptr, 1.0f, Wout + (size_t)n0 * D + k0, D, scr, lane); continue; }
        r -= I_OUT;
        if (r < I_UP) { const int kb = r / 176, nb = r % 176, k0 = 64 * kb, n0 = 32 * nb, j = n0 >> 8, w = n0 & 255, c0 = w < 128 ? 128 * j + w : DFF + 128 * j + (w - 128);
            tr_item(a.w_up + (size_t)k0 * NU + c0, NU, a.ffn_g + k0, 1.0f, Wup + (size_t)n0 * D + k0, D, scr, lane); continue; }
        r -= I_UP;
        { const int kb = r / 32, nb = r % 32, k0 = 64 * kb, n0 = 32 * nb;
            tr_item(a.w_down + (size_t)k0 * D + n0, D, nullptr, 1.0f, Wdn + (size_t)n0 * DFF + k0, DFF, scr, lane); }
    }
    for (int it = blockIdx.x * 512 + tid; it < 256 * 128; it += gridDim.x * 512) {
        const int n = it >> 7, k0 = (it & 127) * 8;
        float wg[16];
#pragma unroll
        for (int r = 0; r < 16; ++r) wg[r] = a.w_gate_up[r * 256 + n];
        float o[8];
#pragma unroll
        for (int kk = 0; kk < 8; ++kk) { const float* wr_ = a.w_in + (size_t)(k0 + kk) * 3088 + 2560; float s = 0.f;
#pragma unroll
            for (int r4 = 0; r4 < 4; ++r4) { const f32x4 w4 = *(const f32x4*)(wr_ + 4 * r4); s += w4[0] * wg[4 * r4] + w4[1] * wg[4 * r4 + 1] + w4[2] * wg[4 * r4 + 2] + w4[3] * wg[4 * r4 + 3]; }
            o[kk] = s * a.attn_g[k0 + kk]; }
        u32x4 w; w.x = cvt_pk_bf16(o[0], o[1]); w.y = cvt_pk_bf16(o[2], o[3]); w.z = cvt_pk_bf16(o[4], o[5]); w.w = cvt_pk_bf16(o[6], o[7]);
        *(u32x4*)(Win + (size_t)(3072 + n) * D + k0) = w;
    }
    for (int it = gw; it < 2048; it += NGW) {
        const int kp = it & 7, cgp = (it >> 3) & 7, b = it >> 6, col = (cgp < 4 ? 1536 + 64 * cgp : 1792 + 64 * (cgp - 4)) + lane;
        const float* xr = a.x + (size_t)b * SEQ * D + 128 * kp; const float* gr = a.attn_g + 128 * kp; const float* wr_ = a.w_in + (size_t)(128 * kp) * 3088 + col;
        float s0 = 0.f, s1 = 0.f, s2 = 0.f, s3 = 0.f;
#pragma unroll 8
        for (int k = 0; k < 128; k += 4) {
            s0 += xr[k] * gr[k] * wr_[(size_t)k * 3088];
            s1 += xr[k + 1] * gr[k + 1] * wr_[(size_t)(k + 1) * 3088];
            s2 += xr[k + 2] * gr[k + 2] * wr_[(size_t)(k + 2) * 3088];
            s3 += xr[k + 3] * gr[k + 3] * wr_[(size_t)(k + 3) * 3088];
        }
        ((float*)(a.ws + WS_QK0))[(kp * 32 + b) * 512 + cgp * 64 + lane] = (s0 + s1) + (s2 + s3);
    }
    bf16_t* xb = (bf16_t*)(a.ws + WS_XB); float* rstd1 = (float*)(a.ws + WS_RSTD1);
    for (int m = gw; m < T; m += NGW) {
        const f32x4* xr = (const f32x4*)(a.x + (size_t)m * D) + lane; f32x4 v[4]; float s = 0.f;
#pragma unroll
        for (int j = 0; j < 4; ++j) { v[j] = xr[64 * j]; s += (v[j][0] * v[j][0] + v[j][1] * v[j][1]) + (v[j][2] * v[j][2] + v[j][3] * v[j][3]); }
        s = wave_sum(s);
        if (lane == 0) rstd1[m] = 1.0f / sqrtf(s * (1.0f / D) + EPS);
        u32x2* o8 = (u32x2*)(xb + (size_t)m * D) + lane;
#pragma unroll
        for (int j = 0; j < 4; ++j) { u32x2 w; w.x = cvt_pk_bf16(v[j][0], v[j][1]); w.y = cvt_pk_bf16(v[j][2], v[j][3]); o8[64 * j] = w; }
    }
}

#ifndef USE_TR
#define USE_TR 1
#endif
DI s16x4 gather4(const LAS unsigned char* base, int pitchB, int row0, int cbase, int lane) {
#if USE_TR
    const int i = lane & 15;
    const LAS unsigned char* p = base + (row0 + (i >> 2)) * pitchB + (cbase + 4 * (i & 3)) * 2;
    return __builtin_amdgcn_ds_read_tr16_b64_v4i16((LAS s16x4*)p);
#else
    const LAS unsigned char* p = base + row0 * pitchB + (cbase + (lane & 15)) * 2;
    s16x4 r;
    r[0] = *(const LAS short*)(p); r[1] = *(const LAS short*)(p + pitchB); r[2] = *(const LAS short*)(p + 2 * pitchB); r[3] = *(const LAS short*)(p + 3 * pitchB);
    return r;
#endif
}
DI bf16x8 cat8(s16x4 lo, s16x4 hi) { return __builtin_shufflevector(lo, hi, 0, 1, 2, 3, 4, 5, 6, 7); }
DI bf16x8 pack8(float a0, float a1, float a2, float a3, float a4, float a5, float a6, float a7) {
    u32x4 w; w.x = cvt_pk_bf16(a0, a1); w.y = cvt_pk_bf16(a2, a3); w.z = cvt_pk_bf16(a4, a5); w.w = cvt_pk_bf16(a6, a7); return __builtin_bit_cast(bf16x8, w);
}

constexpr float SB_CUT = 5.421010862427522e-20f;
constexpr int VPITCH = 144;
DI void sb_wave(const bf16_t* proj, bf16_t* ocat, const float* sbg, int b, int h, int q0, LAS unsigned char* vl, int lane) {
    const int r32 = lane & 31, h2 = lane >> 5;
    const size_t rowbase = (size_t)b * SEQ;
    bf16x8 qf[4];
    { const bf16_t* qp = proj + (rowbase + q0 + r32) * PP + Q_OFF + h * 64 + 8 * h2;
#pragma unroll
      for (int s = 0; s < 4; ++s) qf[s] = *(const bf16x8*)(qp + 16 * s); }
    f32x4 gsb[2][4];
#pragma unroll
    for (int dt = 0; dt < 2; ++dt)
#pragma unroll
        for (int gi = 0; gi < 4; ++gi) gsb[dt][gi] = *(const f32x4*)(sbg + h * 64 + 32 * dt + 8 * gi + 4 * h2);
    f32x16 o0, o1;
#pragma unroll
    for (int r = 0; r < 16; ++r) { o0[r] = 0.f; o1[r] = 0.f; }
    float carry = 1.f;
    const int grp = (lane >> 4) & 1;
    bf16x8 kn[4]; u32x4 vn0, vn1, vn2, vn3;
    { const int k0 = q0;
      const bf16_t* kp = proj + (rowbase + k0 + r32) * PP + K_OFF + h * 64 + 8 * h2;
#pragma unroll
      for (int s = 0; s < 4; ++s) kn[s] = *(const bf16x8*)(kp + 16 * s);
      const bf16_t* vp = proj + (rowbase + k0 + (lane >> 1)) * PP + V_OFF + h * 64 + 32 * (lane & 1);
      vn0 = *(const u32x4*)(vp); vn1 = *(const u32x4*)(vp + 8); vn2 = *(const u32x4*)(vp + 16); vn3 = *(const u32x4*)(vp + 24); }
    for (int kt = q0 >> 5; kt >= 0; --kt) {
        const int k0 = kt * 32; const bool diag = (k0 == q0);
        bf16x8 kf[4];
#pragma unroll
        for (int s = 0; s < 4; ++s) kf[s] = kn[s];
        { LAS unsigned char* dp = vl + (lane >> 1) * VPITCH + 64 * (lane & 1);
          *(LAS u32x4*)(dp) = vn0; *(LAS u32x4*)(dp + 16) = vn1; *(LAS u32x4*)(dp + 32) = vn2; *(LAS u32x4*)(dp + 48) = vn3; }
        if (kt > 0) {
            const int k1 = k0 - 32;
            const bf16_t* kp = proj + (rowbase + k1 + r32) * PP + K_OFF + h * 64 + 8 * h2;
#pragma unroll
            for (int s = 0; s < 4; ++s) kn[s] = *(const bf16x8*)(kp + 16 * s);
            const bf16_t* vp = proj + (rowbase + k1 + (lane >> 1)) * PP + V_OFF + h * 64 + 32 * (lane & 1);
            vn0 = *(const u32x4*)(vp); vn1 = *(const u32x4*)(vp + 8); vn2 = *(const u32x4*)(vp + 16); vn3 = *(const u32x4*)(vp + 24);
        }
        f32x16 z;
#pragma unroll
        for (int r = 0; r < 16; ++r) z[r] = 0.f;
#pragma unroll
        for (int s = 0; s < 4; ++s) z = __builtin_amdgcn_mfma_f32_32x32x16_bf16(kf[s], qf[s], z, 0, 0, 0);
        float om[16], be[16];
#pragma unroll
        for (int r = 0; r < 16; ++r) {
            const float e = fexp2(fminf(z[r], 80.f)); const float rc = __builtin_amdgcn_rcpf(1.f + e);
            float b_ = e * rc, o_ = rc;
            if (diag) { const int kvl = (r & 3) + 8 * (r >> 2) + 4 * h2; if (kvl >= r32) { b_ = 0.f; o_ = 1.f; } }
            be[r] = b_; om[r] = o_;
        }
        float sg[4], ps[4];
#pragma unroll
        for (int gi = 0; gi < 4; ++gi) { sg[gi] = (om[4 * gi] * om[4 * gi + 1]) * (om[4 * gi + 2] * om[4 * gi + 3]); ps[gi] = __shfl_xor(sg[gi], 32); }
        float e[4]; float run = 1.f;
#pragma unroll
        for (int gi = 3; gi >= 0; --gi) {
            const float hi = h2 ? sg[gi] : ps[gi], lo = h2 ? ps[gi] : sg[gi];
            const float e_hi = run; run *= hi; const float e_lo = run; run *= lo;
            e[gi] = h2 ? e_hi : e_lo;
        }
        float w[16];
#pragma unroll
        for (int gi = 0; gi < 4; ++gi) {
            float A = carry * e[gi];
#pragma unroll
            for (int j = 3; j >= 0; --j) { const int r = 4 * gi + j; w[r] = be[r] * A; A *= om[r]; }
        }
        carry *= run;
        asm volatile("s_waitcnt lgkmcnt(0)" ::: "memory");
#pragma unroll
        for (int s = 0; s < 2; ++s) {
            const bf16x8 pf = pack8(w[8 * s], w[8 * s + 1], w[8 * s + 2], w[8 * s + 3], w[8 * s + 4], w[8 * s + 5], w[8 * s + 6], w[8 * s + 7]);
            const bf16x8 va = cat8(gather4(vl, VPITCH, 16 * s + 4 * h2, 16 * grp, lane), gather4(vl, VPITCH, 16 * s + 8 + 4 * h2, 16 * grp, lane));
            const bf16x8 vb = cat8(gather4(vl, VPITCH, 16 * s + 4 * h2, 32 + 16 * grp, lane), gather4(vl, VPITCH, 16 * s + 8 + 4 * h2, 32 + 16 * grp, lane));
            o0 = __builtin_amdgcn_mfma_f32_32x32x16_bf16(va, pf, o0, 0, 0, 0);
            o1 = __builtin_amdgcn_mfma_f32_32x32x16_bf16(vb, pf, o1, 0, 0, 0);
        }
        asm volatile("s_waitcnt lgkmcnt(0)" ::: "memory");
        if (__all(carry < SB_CUT)) break;
    }
    float ss = 0.f;
#pragma unroll
    for (int r = 0; r < 16; ++r) ss += o0[r] * o0[r] + o1[r] * o1[r];
    ss += __shfl_xor(ss, 32);
    const float rs = 1.0f / sqrtf(ss * (1.0f / 64.0f) + EPS);
    bf16_t* op = ocat + (rowbase + q0 + r32) * D + h * 64;
#pragma unroll
    for (int dt = 0; dt < 2; ++dt)
#pragma unroll
        for (int gi = 0; gi < 4; ++gi) {
            const int d = 32 * dt + 8 * gi + 4 * h2; const f32x4 gg = gsb[dt][gi];
            const f32x16& o = dt ? o1 : o0;
            u32x2 wv; wv.x = cvt_pk_bf16(o[4 * gi] * rs * gg[0], o[4 * gi + 1] * rs * gg[1]); wv.y = cvt_pk_bf16(o[4 * gi + 2] * rs * gg[2], o[4 * gi + 3] * rs * gg[3]);
            *(u32x2*)(op + d) = wv;
        }
}

constexpr int GP = 144, GVP = 272;
constexpr int G_QD = 0, G_KI = 64 * GP, G_V = 2 * 64 * GP, G_DEC = G_V + 64 * GVP, G_BUF = 36352, G_SSQ = 2 * G_BUF, G_END = G_SSQ + 2 * 8 * 64 * 4;
static_assert(G_DEC + 256 <= G_BUF && G_END <= GEMM_LDS, "GLA LDS map");
DI void gla_unit(const Args& a, int b, int h, LAS unsigned char* lds) {
    const int tid = threadIdx.x, lane = tid & 63, w = tid >> 6, c = lane & 15, g = lane >> 4;
    const bf16_t* proj = (const bf16_t*)(a.ws + WS_PROJ); const float* b2 = (const float*)(a.ws + WS_B2); bf16_t* ocat = (bf16_t*)(a.ws + WS_OCAT);
    const size_t rowbase = (size_t)b * SEQ;
    f32x4 S[4];
#pragma unroll
    for (int dt = 0; dt < 4; ++dt) S[dt] = (f32x4){0.f, 0.f, 0.f, 0.f};
    const int si = tid >> 3, sc8 = (tid & 7) * 8, sv16 = (tid & 7) * 16;
    float s00;
    {
        const float* qk0 = (const float*)(a.ws + WS_QK0) + b * 512;
        const float rs1 = ((const float*)(a.ws + WS_RSTD1))[rowbase];
        float q0 = 0.f, k0 = 0.f;
#pragma unroll
        for (int kp = 0; kp < 8; ++kp) { q0 += qk0[kp * 32 * 512 + h * 64 + lane]; k0 += qk0[kp * 32 * 512 + 256 + h * 64 + lane]; }
        s00 = wave_sum(q0 * k0) * rs1 * rs1 * 0.125f;
    }
    u32x4 pqv, pkv, pv0, pv1; f32x4 pba, pbb; u32x2 pog[4];
#define GLA_LOAD(nn) do { const size_t t0_ = rowbase + 64 * (nn), row_ = t0_ + si; \
        pqv = *(const u32x4*)(proj + row_ * PP + GQ_OFF + h * 64 + sc8); pkv = *(const u32x4*)(proj + row_ * PP + GK_OFF + h * 64 + sc8); \
        pba = *(const f32x4*)(b2 + row_ * 256 + h * 64 + sc8); pbb = *(const f32x4*)(b2 + row_ * 256 + h * 64 + sc8 + 4); \
        pv0 = *(const u32x4*)(proj + row_ * PP + GV_OFF + h * 128 + sv16); pv1 = *(const u32x4*)(proj + row_ * PP + GV_OFF + h * 128 + sv16 + 8); \
        _Pragma("unroll") for (int it_ = 0; it_ < 4; ++it_) pog[it_] = *(const u32x2*)(proj + (t0_ + 16 * it_ + c) * PP + OG_OFF + h * 128 + 16 * w + 4 * g); } while (0)
#define GLA_FINAL(nn, OV, SV) do { const size_t t0_ = rowbase + 64 * (nn); const LAS float* sq_ = (const LAS float*)(lds + G_SSQ + ((nn) & 1) * 2048); \
        _Pragma("unroll") for (int it = 0; it < 4; ++it) { const int i = 16 * it + c; float tot = 0.f; \
            _Pragma("unroll") for (int ww = 0; ww < 8; ++ww) tot += sq_[ww * 64 + i]; \
            const float rs = __builtin_amdgcn_rsqf(tot * (1.0f / 128.0f) + EPS); \
            u32x2 wv; wv.x = cvt_pk_bf16(OV[it][0] * rs * SV[it][0], OV[it][1] * rs * SV[it][1]); wv.y = cvt_pk_bf16(OV[it][2] * rs * SV[it][2], OV[it][3] * rs * SV[it][3]); \
            *(u32x2*)(ocat + (t0_ + i) * D + 512 + h * 128 + 16 * w + 4 * g) = wv; } } while (0)
    GLA_LOAD(0);
    f32x4 o_prev[4], sil_prev[4];
#pragma unroll
    for (int it = 0; it < 4; ++it) { o_prev[it] = (f32x4){0.f, 0.f, 0.f, 0.f}; sil_prev[it] = o_prev[it]; }
    for (int n = 0; n < 32; ++n) {
        LAS unsigned char* bl_ = lds + (n & 1) * G_BUF;
        f32x4 sil[4];
        {
            const u32x4 qv = pqv, kv = pkv; const f32x4 ba = pba, bb = pbb; const u32x4 v0 = pv0, v1 = pv1;
#pragma unroll
            for (int it = 0; it < 4; ++it) sil[it] = (f32x4){bflo(pog[it].x), bfhi(pog[it].x), bflo(pog[it].y), bfhi(pog[it].y)};
            asm volatile("" : "+v"(sil[0]), "+v"(sil[1]), "+v"(sil[2]), "+v"(sil[3]));
            float qd[8], ki[8];
#pragma unroll
            for (int j = 0; j < 4; ++j) {
                const unsigned qw = qv[j], kw = kv[j];
                const float bl = (2 * j < 4) ? ba[2 * j] : bb[2 * j - 4], bh = (2 * j + 1 < 4) ? ba[2 * j + 1] : bb[2 * j + 1 - 4];
                qd[2 * j] = bflo(qw) * 0.125f * fexp2(bl); qd[2 * j + 1] = bfhi(qw) * 0.125f * fexp2(bh);
                ki[2 * j] = bflo(kw) * fexp2(-bl);         ki[2 * j + 1] = bfhi(kw) * fexp2(-bh);
            }
            *(LAS bf16x8*)(bl_ + G_QD + si * GP + sc8 * 2) = pack8(qd[0], qd[1], qd[2], qd[3], qd[4], qd[5], qd[6], qd[7]);
            *(LAS bf16x8*)(bl_ + G_KI + si * GP + sc8 * 2) = pack8(ki[0], ki[1], ki[2], ki[3], ki[4], ki[5], ki[6], ki[7]);
            *(LAS u32x4*)(bl_ + G_V + si * GVP + sv16 * 2) = v0; *(LAS u32x4*)(bl_ + G_V + si * GVP + sv16 * 2 + 16) = v1;
            if (si == 63) { LAS float* dp = (LAS float*)(bl_ + G_DEC) + sc8;
#pragma unroll
                for (int j = 0; j < 4; ++j) { dp[j] = fexp2(ba[j]); dp[4 + j] = fexp2(bb[j]); } }
        }
        if (n + 1 < 32) GLA_LOAD(n + 1);
        asm volatile("s_waitcnt lgkmcnt(0)" ::: "memory"); __builtin_amdgcn_s_barrier(); asm volatile("" ::: "memory");
        if (n > 0) GLA_FINAL(n - 1, o_prev, sil_prev);
        bf16x8 vT[2], Sb[2];
#pragma unroll
        for (int s = 0; s < 2; ++s) {
            vT[s] = cat8(gather4(bl_ + G_V, GVP, 32 * s + 4 * g, 16 * w, lane), gather4(bl_ + G_V, GVP, 32 * s + 16 + 4 * g, 16 * w, lane));
            Sb[s] = pack8(S[2 * s][0], S[2 * s][1], S[2 * s][2], S[2 * s][3], S[2 * s + 1][0], S[2 * s + 1][1], S[2 * s + 1][2], S[2 * s + 1][3]);
        }
        f32x4 o[4];
#pragma unroll
        for (int it = 0; it < 4; ++it) {
            const LAS unsigned char* qrow = bl_ + G_QD + (16 * it + c) * GP;
            const bf16x8 qn0 = *(const LAS bf16x8*)(qrow + 16 * g), qn1 = *(const LAS bf16x8*)(qrow + 64 + 16 * g);
            f32x4 P[4];
#pragma unroll
            for (int jt = 0; jt < 4; ++jt) {
                P[jt] = (f32x4){0.f, 0.f, 0.f, 0.f};
                if (jt <= it) {
                    const LAS unsigned char* krow = bl_ + G_KI + (16 * jt + c) * GP;
                    const bf16x8 k0 = *(const LAS bf16x8*)(krow + 16 * g), k1 = *(const LAS bf16x8*)(krow + 64 + 16 * g);
                    P[jt] = __builtin_amdgcn_mfma_f32_16x16x32_bf16(k0, qn0, P[jt], 0, 0, 0);
                    P[jt] = __builtin_amdgcn_mfma_f32_16x16x32_bf16(k1, qn1, P[jt], 0, 0, 0);
                    if (jt == it) {
#pragma unroll
                        for (int r = 0; r < 4; ++r) if (4 * g + r > c) P[jt][r] = 0.f;
                        if (it == 0 && n == 0 && lane == 0) P[jt][0] = s00;
                    }
                }
            }
            f32x4 acc = {0.f, 0.f, 0.f, 0.f};
            { const bf16x8 pb = pack8(P[0][0], P[0][1], P[0][2], P[0][3], P[1][0], P[1][1], P[1][2], P[1][3]);
              acc = __builtin_amdgcn_mfma_f32_16x16x32_bf16(vT[0], pb, acc, 0, 0, 0); }
            if (it >= 2) { const bf16x8 pb = pack8(P[2][0], P[2][1], P[2][2], P[2][3], P[3][0], P[3][1], P[3][2], P[3][3]);
              acc = __builtin_amdgcn_mfma_f32_16x16x32_bf16(vT[1], pb, acc, 0, 0, 0); }
#pragma unroll
            for (int s = 0; s < 2; ++s) {
                const s16x4 qa = *(const LAS s16x4*)(qrow + (32 * s + 4 * g) * 2), qb = *(const LAS s16x4*)(qrow + (32 * s + 16 + 4 * g) * 2);
                acc = __builtin_amdgcn_mfma_f32_16x16x32_bf16(Sb[s], cat8(qa, qb), acc, 0, 0, 0);
            }
            o[it] = acc;
        }
#pragma unroll
        for (int dt = 0; dt < 4; ++dt) {
            const f32x4 dec = *(const LAS f32x4*)(bl_ + G_DEC + (16 * dt + 4 * g) * 4);
            f32x4 sacc = S[dt];
#pragma unroll
            for (int s = 0; s < 2; ++s) {
                const bf16x8 ka = cat8(gather4(bl_ + G_KI, GP, 32 * s + 4 * g, 16 * dt, lane), gather4(bl_ + G_KI, GP, 32 * s + 16 + 4 * g, 16 * dt, lane));
                sacc = __builtin_amdgcn_mfma_f32_16x16x32_bf16(ka, vT[s], sacc, 0, 0, 0);
            }
            S[dt] = sacc * dec;
        }
        { LAS float* sq = (LAS float*)(lds + G_SSQ + (n & 1) * 2048);
#pragma unroll
          for (int it = 0; it < 4; ++it) {
            float s = (o[it][0] * o[it][0] + o[it][1] * o[it][1]) + (o[it][2] * o[it][2] + o[it][3] * o[it][3]);
            s += __shfl_xor(s, 16); s += __shfl_xor(s, 32);
            if (g == 0) sq[w * 64 + 16 * it + c] = s;
            o_prev[it] = o[it]; sil_prev[it] = sil[it];
          } }
    }
    asm volatile("s_waitcnt lgkmcnt(0)" ::: "memory"); __builtin_amdgcn_s_barrier(); asm volatile("" ::: "memory");
    GLA_FINAL(31, o_prev, sil_prev);
#undef GLA_LOAD
#undef GLA_FINAL
    __syncthreads();
}

DI void phase_mix(const Args& a, LAS unsigned char* lds, int cidx = 0, int mode = 0) {
    const int tid = threadIdx.x, lane = tid & 63, w = tid >> 6;
    unsigned* ctr = (unsigned*)(a.ws + WS_CTL) + 64 * cidx;
    volatile LAS unsigned* sh = (volatile LAS unsigned*)(lds + MISC_OFF);
    constexpr int NGLA = NB * 4, NSB = NB * 8 * 8, NUNIT = NGLA + NSB;
    unsigned nxt = 0;
    if (tid == 0) nxt = atomicAdd(ctr, 1u);
    for (;;) {
        if (tid == 0) sh[0] = nxt;
        __syncthreads();
        const int u = (int)sh[0];
        __syncthreads();
        if (u >= NUNIT) break;
        if (tid == 0) nxt = atomicAdd(ctr, 1u);
        if (u < NGLA) { if (mode != 1) gla_unit(a, u >> 2, u & 3, lds); }
        else if (mode != 2) {
            const int v = u - NGLA, bh = v >> 3, qb = 7 - (v & 7);
            sb_wave((const bf16_t*)(a.ws + WS_PROJ), (bf16_t*)(a.ws + WS_OCAT), a.sb_g, bh >> 3, bh & 7, qb * 256 + 32 * w, lds + w * 8192, lane);
        }
    }
}

DI void phase_fix(const Args& a) {
    const float* hh = (const float*)(a.ws + WS_HHEAD); const float* ht = (const float*)(a.ws + WS_HTAIL); bf16_t* g = (bf16_t*)(a.ws + WS_G);
    constexpr int PER = 2 * 704;
    for (int it = blockIdx.x * 512 + threadIdx.x; it < 256 * PER; it += gridDim.x * 512) {
        const int pm = it / PER, rem = it % PER, rr = rem / 704, ch = (rem % 704) * 4;
        if ((pm & 7) == 0) continue;
        const int j = ch >> 7, wv = ch & 127, pa = 256 * j + wv, pv = pa + 128;
        const float* t0 = ht + ((size_t)(pm - 1) * 2) * NU; const float* t1 = t0 + NU; const float* h0 = hh + ((size_t)pm * 2) * NU; const float* h1 = h0 + NU;
        const float *m2 = rr == 0 ? t0 : t1, *m1 = rr == 0 ? t1 : h0, *m0 = rr == 0 ? h0 : h1;
        const f32x4 a2 = *(const f32x4*)(m2 + pa), a1 = *(const f32x4*)(m1 + pa), a0 = *(const f32x4*)(m0 + pa);
        const f32x4 v2 = *(const f32x4*)(m2 + pv), v1 = *(const f32x4*)(m1 + pv), v0 = *(const f32x4*)(m0 + pv);
        const f32x4 wa0 = *(const f32x4*)(a.conv_w + ch), wa1 = *(const f32x4*)(a.conv_w + NU + ch), wa2 = *(const f32x4*)(a.conv_w + 2 * NU + ch), ba = *(const f32x4*)(a.conv_b + ch);
        const f32x4 wv0 = *(const f32x4*)(a.conv_w + DFF + ch), wv1 = *(const f32x4*)(a.conv_w + NU + DFF + ch), wv2 = *(const f32x4*)(a.conv_w + 2 * NU + DFF + ch), bv = *(const f32x4*)(a.conv_b + DFF + ch);
        const f32x4 av = ba + wa0 * a2 + wa1 * a1 + wa2 * a0, vv = bv + wv0 * v2 + wv1 * v1 + wv2 * v0;
        float o[4];
#pragma unroll
        for (int c = 0; c < 4; ++c) o[c] = av[c] * vv[c] * __builtin_amdgcn_rcpf(1.f + fexp2(-av[c] * LOG2E));
        u32x2 w; w.x = cvt_pk_bf16(o[0], o[1]); w.y = cvt_pk_bf16(o[2], o[3]);
        *(u32x2*)(g + (size_t)(pm * 256 + rr) * DFF + ch) = w;
    }
}

DI void phase_final(const Args& a) {
    const int lane = threadIdx.x & 63, gw = blockIdx.x * 8 + (threadIdx.x >> 6), NGW = gridDim.x * 8;
    const float* ssq3 = (const float*)(a.ws + WS_SSQ3);
    f32x4 gv[4];
#pragma unroll
    for (int j = 0; j < 4; ++j) gv[j] = ((const f32x4*)a.final_g)[lane + 64 * j];
    for (int m = gw; m < T; m += NGW) {
        const float rs = 1.0f / sqrtf(ssq3[m] * (1.0f / D) + EPS);
        f32x4* xr = (f32x4*)(a.out + (size_t)m * D) + lane;
#pragma unroll
        for (int j = 0; j < 4; ++j) { const f32x4 v = xr[64 * j]; xr[64 * j] = v * rs * gv[j]; }
    }
}

__global__ void __launch_bounds__(512, 2) fwd(Args a) {
    extern __shared__ __attribute__((aligned(16))) unsigned char smem[];
    LAS unsigned char* lds = (LAS unsigned char*)smem;
    const int lo = a.ph_lo, hi = a.ph_hi;
    const int G = gridDim.x, cu = blockIdx.x;
#ifndef PH_MASK
#define PH_MASK 255
#endif
#define IN(k) (((PH_MASK >> (k)) & 1) && lo <= (k) && (k) < hi)
    volatile LAS unsigned* MISC = (volatile LAS unsigned*)(lds + MISC_OFF);
    if (threadIdx.x < 16) MISC[threadIdx.x] = 0u;
    __syncthreads();
    XcdBarrier xbar; xbar.bar = (unsigned*)(a.ws + WS_CTL) + 24576; xbar.x = 0; xbar.st = nullptr;
    if (a.coop) xbar = xcd_barrier_post((unsigned*)(a.ws + WS_CTL) + 24576, MISC + 8);
    if (a.pad == 0x7eadbeef) cg::this_grid().sync();
#define SEAM(k) do { if (a.coop && IN(k) && IN((k) + 1)) { xcd_barrier(xbar); } } while (0)
    if (IN(0)) { phase_prep(a, lds);
#ifdef PROBE_P0
        cg::this_grid().sync(); phase_prep(a, lds);
#endif
#ifdef PROBE_SYNC4
#endif
    }
    SEAM(0);
#ifdef CODE_PAD
    asm volatile(".rept " CODE_PAD_STR "\n\ts_nop 0\n\t.endr" ::: "memory");
#endif
#ifdef PROBE_SYNC4
    xcd_barrier(xbar); xcd_barrier(xbar); xcd_barrier(xbar); xcd_barrier(xbar);
#endif
    if (IN(1)) {
        pg8::Gemm g{(const bf16_t*)(a.ws + WS_XB), (const bf16_t*)(a.ws + WS_WIN), T, N1, D}; pg8::StaticOrder S; S.init(T, N1, G, cu);
        Epi1 E{(bf16_t*)(a.ws + WS_PROJ), (float*)(a.ws + WS_B2), (const float*)(a.ws + WS_RSTD1), a.b_gate_up, a.gla_g};
        pg8::gemm_phase<Epi1, pg8::StaticOrder>(lds, g, S, E);
#ifdef PROBE_G1
        cg::this_grid().sync(); pg8::gemm_phase<Epi1, pg8::StaticOrder>(lds, g, S, E);
#endif
    }
    SEAM(1);
    if (IN(2)) { phase_mix(a, lds);
#ifdef PROBE_MIX2
        cg::this_grid().sync(); phase_mix(a, lds, 1, PROBE_MIX2);
#endif
    }
    SEAM(2);
    if (IN(3)) {
        pg8::Gemm g{(const bf16_t*)(a.ws + WS_OCAT), (const bf16_t*)(a.ws + WS_WOUT), T, D, D}; pg8::StaticOrder S; S.init(T, D, G, cu);
        EpiRes<true> E{a.x, ((G == 256) && a.coop) ? nullptr : a.out, (bf16_t*)(a.ws + WS_XB), (float*)(a.ws + WS_SSQ2), ((G == 256) && a.coop) ? (const bf16_t*)(a.ws + WS_XB) : nullptr};
        pg8::gemm_phase<EpiRes<true>, pg8::StaticOrder>(lds, g, S, E);
    }
    SEAM(3);
    if (IN(4)) {
        pg8::Gemm g{(const bf16_t*)(a.ws + WS_XB), (const bf16_t*)(a.ws + WS_WUP), T, NU, D}; pg8::StaticOrder S; S.init(T, NU, G, cu);
        Epi3 E{(bf16_t*)(a.ws + WS_G), (const float*)(a.ws + WS_SSQ2), a.conv_w, a.conv_b, (float*)(a.ws + WS_HHEAD), (float*)(a.ws + WS_HTAIL), (LAS float*)(lds + HALO_OFF), lds + PF_OFF};
        pg8::gemm_phase<Epi3, pg8::StaticOrder>(lds, g, S, E);
#ifdef PROBE_G3
        cg::this_grid().sync(); pg8::gemm_phase<Epi3, pg8::StaticOrder>(lds, g, S, E);
#endif
    }
    SEAM(4);
    if (IN(5)) { phase_fix(a); }
    SEAM(5);
    const bool fused_final = (G == 256) && a.coop;
    if (IN(6)) {
        pg8::Gemm g{(const bf16_t*)(a.ws + WS_G), (const bf16_t*)(a.ws + WS_WDN), T, D, DFF}; pg8::StaticOrder S; S.init(T, D, G, cu, 1);
        if (fused_final) {
            Epi4F E{a.out, (const bf16_t*)(a.ws + WS_XB), a.out, a.final_g, (float*)(a.ws + WS_XCH), (unsigned*)(a.ws + WS_CTL) + 4096, (LAS float*)(lds + HALO_OFF)};
            pg8::gemm_phase<Epi4F, pg8::StaticOrder>(lds, g, S, E);
        } else {
            EpiRes<false> E{a.out, a.out, nullptr, (float*)(a.ws + WS_SSQ3), nullptr};
            pg8::gemm_phase<EpiRes<false>, pg8::StaticOrder>(lds, g, S, E);
        }
    }
    if (!fused_final) {
        SEAM(6);
        if (IN(7)) { phase_final(a); }
    }
#undef IN
#undef SEAM
}

#ifndef ONE_LAUNCH
#define ONE_LAUNCH 1
#endif
extern "C" void kernel_launch(void* const* d_in, const int* in_sizes, int n_in, void* d_out, int out_size, void* d_ws, size_t ws_size, hipStream_t stream) {
    static int grid = 0;
    if (grid == 0) {
        if (n_in != 14 || ws_size < WS_END) { fprintf(stderr, "kernel_launch: unexpected inputs (n_in %d, ws %zu)\n", n_in, ws_size); grid = -1; return; }
        int dev = 0, cus = 0, per_cu = 0;
        hipGetDevice(&dev); hipDeviceGetAttribute(&cus, hipDeviceAttributeMultiprocessorCount, dev);
        if (hipFuncSetAttribute((const void*)fwd, hipFuncAttributeMaxDynamicSharedMemorySize, LDS_BYTES) != hipSuccess) { fprintf(stderr, "kernel_launch: hipFuncSetAttribute failed\n"); grid = -1; return; }
        hipOccupancyMaxActiveBlocksPerMultiprocessor(&per_cu, (const void*)fwd, 512, LDS_BYTES);
        (void)hipGetLastError();
        if (per_cu < 1) per_cu = 1;
        grid = cus * per_cu;
        if (grid != 256) fprintf(stderr, "kernel_launch: note: grid %d (cus %d x %d)\n", grid, cus, per_cu);
    }
    if (grid < 0) return;
    hipMemsetAsync((char*)d_ws + WS_CTL, 0, 768 * 1024, stream);
    Args a{};
    a.x = (const float*)d_in[0]; a.attn_g = (const float*)d_in[1]; a.w_in = (const float*)d_in[2]; a.w_gate_up = (const float*)d_in[3]; a.b_gate_up = (const float*)d_in[4];
    a.sb_g = (const float*)d_in[5]; a.gla_g = (const float*)d_in[6]; a.w_out = (const float*)d_in[7]; a.ffn_g = (const float*)d_in[8]; a.w_up = (const float*)d_in[9];
    a.conv_w = (const float*)d_in[10]; a.conv_b = (const float*)d_in[11]; a.w_down = (const float*)d_in[12]; a.final_g = (const float*)d_in[13];
    a.out = (float*)d_out; a.ws = (unsigned char*)d_ws;
#if ONE_LAUNCH
    a.ph_lo = 0; a.ph_hi = 8; a.coop = 1;
    void* args[] = {&a};
    hipError_t e = hipLaunchCooperativeKernel((const void*)fwd, dim3(grid), dim3(512), args, LDS_BYTES, stream);
    if (e != hipSuccess) fprintf(stderr, "cooperative launch failed: %s (grid %d)\n", hipGetErrorString(e), grid);
#else
    for (int p = 0; p < 8; ++p) { a.ph_lo = p; a.ph_hi = p + 1; a.coop = 0; hipLaunchKernelGGL(fwd, dim3(grid), dim3(512), LDS_BYTES, stream, a); }
#endif
}
```

```cpp
#include <hip/hip_runtime.h>
#include <hip/hip_cooperative_groups.h>
#include <cstdio>
#include <cstdint>
namespace cg = cooperative_groups;

#define DI __device__ __forceinline__
#define LAS __attribute__((address_space(3)))
typedef unsigned short bf16_t;
typedef short bf16x8 __attribute__((ext_vector_type(8)));
typedef short s16x4 __attribute__((ext_vector_type(4)));
typedef float f32x4 __attribute__((ext_vector_type(4)));
typedef float f32x2 __attribute__((ext_vector_type(2)));
typedef float f32x16 __attribute__((ext_vector_type(16)));
typedef unsigned u32x4 __attribute__((ext_vector_type(4)));
typedef unsigned u32x2 __attribute__((ext_vector_type(2)));
typedef __bf16 bf16x2_t __attribute__((ext_vector_type(2)));

constexpr int T = 65536, SEQ = 2048, NB = 32, D = 1024;
constexpr int PP = 3072;
constexpr int Q_OFF = 0, K_OFF = 512, V_OFF = 1024, GQ_OFF = 1536, GK_OFF = 1792, GV_OFF = 2048, OG_OFF = 2560;
constexpr int N1 = 3328;
constexpr int DFF = 2816, NU = 5632;
constexpr float EPS = 1e-6f;
constexpr float LOG2E = 1.4426950408889634f;
constexpr float QSCALE = 0.125f * LOG2E;

constexpr size_t MiB = 1u << 20;
constexpr size_t WS_CTL = 0;
constexpr size_t WS_SSQ2 = 256 * 1024, WS_SSQ3 = 512 * 1024, WS_RSTD1 = 768 * 1024;
constexpr size_t WS_QK0 = 1 * MiB;
constexpr size_t WS_WIN = 2 * MiB, WS_WOUT = 9 * MiB, WS_WUP = 11 * MiB, WS_WDN = 22 * MiB;
constexpr size_t WS_HHEAD = 28 * MiB, WS_HTAIL = 39 * MiB;
constexpr size_t WS_XCH = 50 * MiB;
constexpr size_t WS_XB = 64 * MiB;
constexpr size_t WS_PROJ = 192 * MiB;
constexpr size_t WS_B2 = 576 * MiB;
constexpr size_t WS_OCAT = 640 * MiB;
constexpr size_t WS_G = 192 * MiB;
constexpr size_t WS_END = 768 * MiB;

constexpr int GEMM_LDS = 131072;
constexpr int HALO_OFF = GEMM_LDS;
constexpr int MISC_OFF = HALO_OFF + 10240;
constexpr int PF_OFF = MISC_OFF + 64;
constexpr int LDS_BYTES = 152576;

DI unsigned cvt_pk_bf16(float lo, float hi) { f32x2 v = {lo, hi}; bf16x2_t b = __builtin_convertvector(v, bf16x2_t); return __builtin_bit_cast(unsigned, b); }
DI float bf2f(unsigned short v) { return __uint_as_float(((unsigned)v) << 16); }
DI float bflo(unsigned w) { return __uint_as_float(w << 16); }
DI float bfhi(unsigned w) { return __uint_as_float(w & 0xffff0000u); }
DI float fexp2(float x) { return __builtin_amdgcn_exp2f(x); }
DI float flog2(float x) { return __builtin_amdgcn_logf(x); }
DI float wave_sum(float v) {
#pragma unroll
    for (int o = 1; o < 64; o <<= 1) v += __shfl_xor(v, o);
    return v;
}
template <int CTRL, bool BC> DI float dppf(float old, float src) {
    return __int_as_float(__builtin_amdgcn_update_dpp(__float_as_int(old), __float_as_int(src), CTRL, 0xf, 0xf, BC));
}

namespace pg8 {
constexpr int BM = 256, BK = 64, HALF = 128, HTB = HALF * BK * 2, STAGE_BYTES = 8 * HTB, NXCD = 8, WGM = 8;
DI int lds_byte(int r, int c) { const int st = (r >> 4) * 2 + (c >> 5), rr = r & 15, cc = c & 31, ob = rr * 64 + cc * 2; return st * 1024 + (ob ^ (((ob >> 9) & 1) << 5)); }
DI void stage_rc(int b, int& R, int& C) { const int st = b / 1024, sb = b % 1024, swz = sb ^ (((sb >> 9) & 1) << 5); R = (st >> 1) * 16 + swz / 64; C = (st & 1) * 32 + (swz % 64) / 2; }
DI int perm32(int rho) { const int n = rho >> 4, i = rho & 15; return 8 * (i >> 2) + 4 * n + (i & 3); }
struct Unit { int pm, pn; };
struct Gemm { const bf16_t* A; const bf16_t* Bt; int M, N, K; };
struct StaticOrder {
    int nM, nN, nwg, G, c, rev;
    DI void init(int M, int N, int G_, int c_, int rev_ = 0) { nM = M / BM; nN = N / BM; nwg = nM * nN; G = G_; c = c_; rev = (rev_ && nwg % G_ == 0) ? nwg / G_ : 0; }
    DI bool next(int i, Unit& u) const {
        if (rev) { if (i >= rev) return false; i = rev - 1 - i; }
        const long L = (long)i * G + c; if (L >= nwg) return false;
        int wgid = (int)L; { const int q = nwg / NXCD, r = nwg % NXCD, xcd = wgid % NXCD, off = wgid / NXCD; wgid = (xcd < r ? xcd * (q + 1) : r * (q + 1) + (xcd - r) * q) + off; }
        const int nig = WGM * nN, gid = wgid / nig, fm = gid * WGM, gsz = (nM - fm) < WGM ? (nM - fm) : WGM;
        u.pm = fm + ((wgid % nig) % gsz); u.pn = (wgid % nig) / gsz; return true;
    }
};

template <class Epi, class Sched, bool ALIGN_EPI = true, bool SP2 = true>
DI void gemm_phase(LAS unsigned char* lds, const Gemm g, const Sched& S, const Epi& E) {
    const int tid = threadIdx.x, wid = __builtin_amdgcn_readfirstlane(tid >> 6), lane = tid & 63, wr = wid >> 2, wc = wid & 3, fr = lane & 15, fq = lane >> 4;
    const int K = g.K, nt = K / BK;
    unsigned voffA[2], voffB[2];
#pragma unroll
    for (int i = 0; i < 2; ++i) { int R, C; stage_rc(tid * 16 + i * 8192, R, C); const int Rb = Epi::PERM ? ((R & ~31) + perm32(R & 31)) : R;
        const int Ra = Epi::APERM ? ((R & ~63) + 4 * (R & 15) + ((R >> 4) & 3)) : R;
        voffA[i] = (unsigned)(Ra * K + C) * 2u; voffB[i] = (unsigned)(Rb * K + C) * 2u; }
    const size_t kstep = (size_t)(BK * 2);
    const size_t hstep = (size_t)HALF * K * 2;
    const size_t tstep = 2 * hstep;
    const unsigned ldsw = (unsigned)wid * 1024u;
    const int aoff = lds_byte(wr * 64 + fr, fq * 8), boff = lds_byte(wc * 32 + fr, fq * 8);
#define PG8_SA(b, h) (((b) * 2 + (h)) * HTB)
#define PG8_SB(b, h) ((4 + (b) * 2 + (h)) * HTB)
#define PG8_STAGE(bufoff, gbase, voff) do { _Pragma("unroll") for (int _i = 0; _i < 2; ++_i) \
        __builtin_amdgcn_global_load_lds((const unsigned*)((const char*)(gbase) + (voff)[_i]), (LAS unsigned*)(lds + (bufoff) + ldsw + _i * 8192), 16, 0, 0); } while (0)
#define PG8_LDA(dst, b, h) do { _Pragma("unroll") for (int m = 0; m < 4; ++m) _Pragma("unroll") for (int k = 0; k < 2; ++k) dst[m][k] = *(const LAS bf16x8*)(lds + PG8_SA(b, h) + aoff + m * 2048 + k * 1024); } while (0)
#define PG8_LDB(dst, b, h) do { _Pragma("unroll") for (int n = 0; n < 2; ++n) _Pragma("unroll") for (int k = 0; k < 2; ++k) dst[n][k] = *(const LAS bf16x8*)(lds + PG8_SB(b, h) + boff + n * 2048 + k * 1024); } while (0)
#define PG8_MMA(ai, bj, At, Bt) do { __builtin_amdgcn_s_setprio(1); _Pragma("unroll") for (int m = 0; m < 4; ++m) _Pragma("unroll") for (int n = 0; n < 2; ++n) _Pragma("unroll") for (int k = 0; k < 2; ++k) \
        acc[ai][bj][m][n] = __builtin_amdgcn_mfma_f32_16x16x32_bf16(Bt[n][k], At[m][k], acc[ai][bj][m][n], 0, 0, 0); __builtin_amdgcn_s_setprio(0); } while (0)
#define PG8_WAIT_V(n) asm volatile("s_waitcnt vmcnt(" #n ")" ::: "memory")
#define PG8_WAIT_L(n) asm volatile("s_waitcnt lgkmcnt(" #n ")" ::: "memory")
#define PG8_BAR __builtin_amdgcn_s_barrier()
#define PG8_SCHED __builtin_amdgcn_sched_barrier(0)
    Unit cur, nxt; int ui = 0;
    if (!S.next(0, cur)) return;
    f32x4 acc[2][2][4][2];
#pragma unroll
    for (int a = 0; a < 2; ++a)
#pragma unroll
        for (int b = 0; b < 2; ++b)
#pragma unroll
            for (int m = 0; m < 4; ++m)
#pragma unroll
                for (int n = 0; n < 2; ++n) acc[a][b][m][n] = (f32x4){0.f, 0.f, 0.f, 0.f};
    bf16x8 At[4][2], B0[2][2], B1[2][2];
    const char* cA = (const char*)g.A + (size_t)cur.pm * tstep; const char* cB = (const char*)g.Bt + (size_t)cur.pn * tstep;
    if constexpr (Epi::PF) { E.prefetch(cur, 0, wid, lane); PG8_WAIT_V(0); PG8_BAR; }
    if constexpr (SP2) {
        PG8_STAGE(PG8_SB(0, 0), cB, voffB); PG8_STAGE(PG8_SB(0, 1), cB + hstep, voffB); PG8_STAGE(PG8_SA(0, 0), cA, voffA); PG8_STAGE(PG8_SA(0, 1), cA + hstep, voffA);
        if (wr == 1) PG8_BAR;
        PG8_WAIT_V(2); PG8_BAR;
        PG8_STAGE(PG8_SB(1, 0), cB + kstep, voffB); PG8_STAGE(PG8_SA(1, 0), cA + kstep, voffA); PG8_STAGE(PG8_SB(1, 1), cB + hstep + kstep, voffB);
        PG8_WAIT_V(6); PG8_BAR;
    } else {
        PG8_STAGE(PG8_SB(0, 0), cB, voffB); PG8_STAGE(PG8_SA(0, 0), cA, voffA); PG8_STAGE(PG8_SB(0, 1), cB + hstep, voffB); PG8_STAGE(PG8_SA(0, 1), cA + hstep, voffA);
        if (wr == 1) PG8_BAR;
        PG8_WAIT_V(4); PG8_BAR;
        PG8_STAGE(PG8_SB(1, 0), cB + kstep, voffB); PG8_STAGE(PG8_SA(1, 0), cA + kstep, voffA); PG8_STAGE(PG8_SB(1, 1), cB + hstep + kstep, voffB);
        PG8_WAIT_V(6); PG8_BAR;
    }
    for (;;) {
        const bool has_next = S.next(ui + 1, nxt);
        const char* nA = has_next ? (const char*)g.A + (size_t)nxt.pm * tstep : cA; const char* nB = has_next ? (const char*)g.Bt + (size_t)nxt.pn * tstep : cB;
        for (int t = 0; t < nt; t += 2) {
            const bool last = (t == nt - 2);
            const char* a1 = cA + (size_t)(t + 1) * kstep;
            const char* a2 = last ? nA : cA + (size_t)(t + 2) * kstep; const char* b2 = last ? nB : cB + (size_t)(t + 2) * kstep;
            const char* a3 = a2 + kstep; const char* b3 = b2 + kstep;
            if constexpr (SP2) {
            PG8_LDB(B0, 0, 0); PG8_LDB(B1, 0, 1); PG8_SCHED; PG8_LDA(At, 0, 0); PG8_STAGE(PG8_SA(1, 1), a1 + hstep, voffA);
            PG8_WAIT_V(8); PG8_WAIT_L(0); PG8_BAR; PG8_MMA(0, 0, At, B0); PG8_MMA(0, 1, At, B1); PG8_BAR; PG8_SCHED;
            PG8_LDA(At, 0, 1); PG8_STAGE(PG8_SB(0, 0), b2, voffB); PG8_STAGE(PG8_SB(0, 1), b2 + hstep, voffB); PG8_STAGE(PG8_SA(0, 0), a2, voffA);
            PG8_WAIT_V(8); PG8_WAIT_L(0); PG8_BAR; PG8_MMA(1, 0, At, B0); PG8_MMA(1, 1, At, B1); PG8_BAR; PG8_SCHED;
            PG8_LDB(B0, 1, 0); PG8_LDB(B1, 1, 1); PG8_SCHED; PG8_LDA(At, 1, 0); PG8_STAGE(PG8_SA(0, 1), a2 + hstep, voffA);
            PG8_WAIT_V(8); PG8_WAIT_L(0); PG8_BAR; PG8_MMA(0, 0, At, B0); PG8_MMA(0, 1, At, B1); PG8_BAR; PG8_SCHED;
            PG8_LDA(At, 1, 1); PG8_STAGE(PG8_SB(1, 0), b3, voffB); PG8_STAGE(PG8_SB(1, 1), b3 + hstep, voffB); PG8_STAGE(PG8_SA(1, 0), a3, voffA);
            PG8_WAIT_V(8); PG8_WAIT_L(0); PG8_BAR; PG8_MMA(1, 0, At, B0); PG8_MMA(1, 1, At, B1); PG8_BAR; PG8_SCHED;
            } else {
            PG8_LDB(B0, 0, 0); PG8_SCHED; PG8_LDA(At, 0, 0); PG8_STAGE(PG8_SA(1, 1), a1 + hstep, voffA);
            PG8_WAIT_L(8); PG8_BAR; PG8_WAIT_L(0); PG8_MMA(0, 0, At, B0); PG8_BAR; PG8_SCHED;
            PG8_LDB(B1, 0, 1); PG8_STAGE(PG8_SB(0, 0), b2, voffB);
            PG8_BAR; PG8_WAIT_L(0); PG8_MMA(0, 1, At, B1); PG8_BAR;
            PG8_LDA(At, 0, 1); PG8_STAGE(PG8_SA(0, 0), a2, voffA);
            PG8_BAR; PG8_WAIT_L(0); PG8_MMA(1, 0, At, B0); PG8_BAR; PG8_SCHED;
            PG8_STAGE(PG8_SB(0, 1), b2 + hstep, voffB);
            PG8_WAIT_V(6); PG8_BAR; PG8_MMA(1, 1, At, B1); PG8_BAR;
            PG8_LDB(B0, 1, 0); PG8_SCHED; PG8_LDA(At, 1, 0); PG8_STAGE(PG8_SA(0, 1), a2 + hstep, voffA);
            PG8_WAIT_L(8); PG8_BAR; PG8_WAIT_L(0); PG8_MMA(0, 0, At, B0); PG8_BAR; PG8_SCHED;
            PG8_LDB(B1, 1, 1); PG8_STAGE(PG8_SB(1, 0), b3, voffB);
            PG8_BAR; PG8_WAIT_L(0); PG8_MMA(0, 1, At, B1); PG8_BAR;
            PG8_LDA(At, 1, 1); PG8_STAGE(PG8_SA(1, 0), a3, voffA);
            PG8_BAR; PG8_WAIT_L(0); PG8_MMA(1, 0, At, B0); PG8_BAR; PG8_SCHED;
            PG8_STAGE(PG8_SB(1, 1), b3 + hstep, voffB);
            PG8_WAIT_V(6); PG8_BAR; PG8_MMA(1, 1, At, B1); PG8_BAR;
            }
        }
        if constexpr (ALIGN_EPI) { if (wr == 0) PG8_BAR; }
        if constexpr (Epi::PF) E(acc, cur, wr, wc, fr, fq, ui, has_next, nxt, wid, lane); else E(acc, cur, wr, wc, fr, fq);
        if (!has_next) break;
#pragma unroll
        for (int a = 0; a < 2; ++a)
#pragma unroll
            for (int b = 0; b < 2; ++b)
#pragma unroll
                for (int m = 0; m < 4; ++m)
#pragma unroll
                    for (int n = 0; n < 2; ++n) acc[a][b][m][n] = (f32x4){0.f, 0.f, 0.f, 0.f};
        cur = nxt; cA = nA; cB = nB; ++ui;
        if constexpr (ALIGN_EPI) { if (wr == 1) PG8_BAR; }
    }
    PG8_WAIT_V(0);
    if constexpr (!ALIGN_EPI) { if (wr == 0) PG8_BAR; }
    PG8_BAR;
#undef PG8_SA
#undef PG8_SB
#undef PG8_STAGE
#undef PG8_LDA
#undef PG8_LDB
#undef PG8_MMA
#undef PG8_WAIT_V
#undef PG8_WAIT_L
#undef PG8_BAR
#undef PG8_SCHED
}
}
using pg8::Unit;
typedef f32x4 Acc[2][2][4][2];

struct Epi1 {
    static constexpr bool PERM = true, PF = false, APERM = false;
    bf16_t* proj; float* b2; const float* rstd; const float* bgate; const float* glag;
    DI void operator()(Acc& acc, const Unit& u, int wr, int wc, int fr, int fq) const {
        const int row0 = u.pm * 256 + wr * 64 + fr;
        if (u.pn < 12) {
            const int col0 = u.pn * 256 + wc * 32 + 8 * fq;
            const bool isog = u.pn >= 10;
            f32x4 gg[2][2];
#pragma unroll
            for (int bj = 0; bj < 2; ++bj) { gg[bj][0] = isog ? *(const f32x4*)(glag + col0 - OG_OFF + bj * 128) : (f32x4){1.f, 1.f, 1.f, 1.f}; gg[bj][1] = isog ? *(const f32x4*)(glag + col0 - OG_OFF + bj * 128 + 4) : (f32x4){1.f, 1.f, 1.f, 1.f}; }
#pragma unroll
            for (int ai = 0; ai < 2; ++ai)
#pragma unroll
                for (int m = 0; m < 4; ++m) {
                    const int row = row0 + ai * 128 + m * 16; const float sc = rstd[row];
                    bf16_t* rowp = proj + (size_t)row * PP + col0;
#pragma unroll
                    for (int bj = 0; bj < 2; ++bj) { f32x4 v0 = acc[ai][bj][m][0] * sc, v1 = acc[ai][bj][m][1] * sc;
                        if (isog) {
#pragma unroll
                            for (int c = 0; c < 4; ++c) { v0[c] = v0[c] * __builtin_amdgcn_rcpf(1.f + fexp2(-v0[c] * LOG2E)) * gg[bj][0][c]; v1[c] = v1[c] * __builtin_amdgcn_rcpf(1.f + fexp2(-v1[c] * LOG2E)) * gg[bj][1][c]; }
                        }
                        u32x4 w; w.x = cvt_pk_bf16(v0[0], v0[1]); w.y = cvt_pk_bf16(v0[2], v0[3]); w.z = cvt_pk_bf16(v1[0], v1[1]); w.w = cvt_pk_bf16(v1[2], v1[3]);
                        *(u32x4*)(rowp + bj * 128) = w; }
                }
        } else {
            const int c0 = wc * 32 + 8 * fq;
            const int lane = threadIdx.x & 63;
#pragma unroll
            for (int ai = 0; ai < 2; ++ai) {
                float sc[4];
#pragma unroll
                for (int m = 0; m < 4; ++m) sc[m] = rstd[row0 + ai * 128 + m * 16];
#pragma unroll
                for (int bj = 0; bj < 2; ++bj)
#pragma unroll
                    for (int n = 0; n < 2; ++n) {
                        const int cc = c0 + 128 * bj + 4 * n;
                        const f32x4 bias = *(const f32x4*)(bgate + cc);
                        f32x4 carry = {0.f, 0.f, 0.f, 0.f};
#pragma unroll
                        for (int m = 0; m < 4; ++m) {
                            const f32x4 v = acc[ai][bj][m][n] * sc[m] + bias;
                            f32x4 la;
#pragma unroll
                            for (int c = 0; c < 4; ++c) {
                                const float x = v[c];
                                float l = fminf(x, 0.f) * LOG2E - flog2(1.f + fexp2(-fabsf(x) * LOG2E));
                                l *= (1.0f / 16.0f);
                                l += dppf<0x111, true>(0.f, l);
                                l += dppf<0x112, true>(0.f, l);
                                l += dppf<0x114, true>(0.f, l);
                                l += dppf<0x118, true>(0.f, l);
                                l += carry[c];
                                carry[c] = __shfl(l, (lane & 48) | 15);
                                la[c] = l;
                            }
                            *(f32x4*)(b2 + (size_t)(row0 + ai * 128 + m * 16) * 256 + cc) = la;
                        }
                    }
            }
        }
    }
};

template <bool WB> struct EpiRes {
    static constexpr bool PERM = true, PF = false, APERM = false;
    const float* base; float* out; bf16_t* outb; float* ssq; const bf16_t* baseb;
    DI void operator()(Acc& acc, const Unit& u, int wr, int wc, int fr, int fq) const {
        const int row0 = u.pm * 256 + wr * 64 + fr, col0 = u.pn * 256 + wc * 32 + 8 * fq;
#pragma unroll
        for (int ai = 0; ai < 2; ++ai)
#pragma unroll
            for (int m = 0; m < 4; ++m) {
                const int row = row0 + ai * 128 + m * 16; const size_t off = (size_t)row * D + col0; float s = 0.f;
#pragma unroll
                for (int bj = 0; bj < 2; ++bj) {
                    f32x4 b0, b1;
                    if (baseb) { const u32x4 rb = *(const u32x4*)(baseb + off + bj * 128); b0 = (f32x4){bflo(rb.x), bfhi(rb.x), bflo(rb.y), bfhi(rb.y)}; b1 = (f32x4){bflo(rb.z), bfhi(rb.z), bflo(rb.w), bfhi(rb.w)}; }
                    else { b0 = *(const f32x4*)(base + off + bj * 128); b1 = *(const f32x4*)(base + off + bj * 128 + 4); }
                    const f32x4 v0 = acc[ai][bj][m][0] + b0, v1 = acc[ai][bj][m][1] + b1;
                    if (out) { *(f32x4*)(out + off + bj * 128) = v0; *(f32x4*)(out + off + bj * 128 + 4) = v1; }
                    s += (v0[0] * v0[0] + v0[1] * v0[1]) + (v0[2] * v0[2] + v0[3] * v0[3]) + (v1[0] * v1[0] + v1[1] * v1[1]) + (v1[2] * v1[2] + v1[3] * v1[3]);
                    if (WB) { u32x4 w; w.x = cvt_pk_bf16(v0[0], v0[1]); w.y = cvt_pk_bf16(v0[2], v0[3]); w.z = cvt_pk_bf16(v1[0], v1[1]); w.w = cvt_pk_bf16(v1[2], v1[3]);
                        *(u32x4*)(outb + off + bj * 128) = w; }
                }
                s += __shfl_xor(s, 16); s += __shfl_xor(s, 32);
                if (fq == 0) atomicAdd(ssq + row, s);
            }
    }
};

DI f32x4 rot_prev(const f32x4& cur, const f32x4& prev, int fr, int which) {
    f32x4 r;
#pragma unroll
    for (int c = 0; c < 4; ++c) {
        if (which == 1) { const float t = dppf<0x10F, true>(0.f, prev[c]); r[c] = dppf<0x111, false>(t, cur[c]); }
        else            { const float t = dppf<0x10E, true>(0.f, prev[c]); r[c] = dppf<0x112, false>(t, cur[c]); }
    }
    return r;
}
struct Epi3 {
    static constexpr bool PERM = true, PF = true, APERM = true;
    bf16_t* g; const float* ssq2; const float* convw; const float* convb; float* hhead; float* htail; LAS float* halo; LAS unsigned char* pf;
    DI void prefetch(const Unit& u, int par, int wid, int lane) const {
        LAS unsigned char* buf = pf + par * 5120;
        if (wid < 4) {
            const int k = 2 * wid + (lane >> 5), chunk = lane & 31, kk = k & 3;
            const float* src = (kk == 3 ? convb : convw + kk * NU) + (k >= 4 ? DFF : 0) + u.pn * 128 + 4 * chunk;
            __builtin_amdgcn_global_load_lds((const unsigned*)src, (LAS unsigned*)(buf + wid * 1024), 16, 0, 0);
        } else if (wid == 4) {
            __builtin_amdgcn_global_load_lds((const unsigned*)(ssq2 + u.pm * 256 + 4 * lane), (LAS unsigned*)(buf + 4096), 16, 0, 0);
        }
    }
    DI void operator()(Acc& acc, const Unit& u, int wr, int wc, int fr, int fq, int ui, bool has_next, const Unit& nxt, int wid, int lane) const {
        const int rowb = u.pm * 256 + wr * 64 + 4 * fr;
        const int cl = wc * 32 + 8 * fq;
        if (has_next) prefetch(nxt, (ui + 1) & 1, wid, lane);
        const LAS unsigned char* cb = pf + (ui & 1) * 5120;
#pragma unroll
        for (int ai = 0; ai < 2; ++ai) {
            const f32x4 sq = *(const LAS f32x4*)(cb + 4096 + (ai * 128 + wr * 64 + 4 * fr) * 4);
#pragma unroll
            for (int m = 0; m < 4; ++m) { const float sc = __builtin_amdgcn_rsqf(sq[m] * (1.0f / D) + EPS);
#pragma unroll
                for (int bj = 0; bj < 2; ++bj) { acc[ai][bj][m][0] *= sc; acc[ai][bj][m][1] *= sc; } } }
        if (fr == 15) {
#pragma unroll
            for (int ai = 0; ai < 2; ++ai)
#pragma unroll
                for (int r = 0; r < 2; ++r) {
                    LAS float* hp = halo + ((2 * ai + wr + 1) * 2 + r) * 256 + cl;
#pragma unroll
                    for (int bj = 0; bj < 2; ++bj) { *(LAS f32x4*)(hp + bj * 128) = acc[ai][bj][2 + r][0]; *(LAS f32x4*)(hp + bj * 128 + 4) = acc[ai][bj][2 + r][1]; }
                }
            if (wr == 0) { const f32x4 z = {0.f, 0.f, 0.f, 0.f};
#pragma unroll
                for (int r = 0; r < 2; ++r) { LAS float* hp = halo + r * 256 + cl; *(LAS f32x4*)(hp) = z; *(LAS f32x4*)(hp + 4) = z; *(LAS f32x4*)(hp + 128) = z; *(LAS f32x4*)(hp + 132) = z; } }
            if (wr == 1) {
#pragma unroll
                for (int r = 0; r < 2; ++r) { float* tp = htail + ((size_t)u.pm * 2 + r) * NU + u.pn * 256 + cl;
#pragma unroll
                    for (int bj = 0; bj < 2; ++bj) { *(f32x4*)(tp + bj * 128) = acc[1][bj][2 + r][0]; *(f32x4*)(tp + bj * 128 + 4) = acc[1][bj][2 + r][1]; } } }
        }
        if (fr == 0 && wr == 0) {
#pragma unroll
            for (int r = 0; r < 2; ++r) { float* tp = hhead + ((size_t)u.pm * 2 + r) * NU + u.pn * 256 + cl;
#pragma unroll
                for (int bj = 0; bj < 2; ++bj) { *(f32x4*)(tp + bj * 128) = acc[0][bj][r][0]; *(f32x4*)(tp + bj * 128 + 4) = acc[0][bj][r][1]; } } }
        asm volatile("s_waitcnt lgkmcnt(0)" ::: "memory"); __builtin_amdgcn_s_barrier(); asm volatile("" ::: "memory");
        const int ch = u.pn * 128 + cl;
#pragma unroll
        for (int n = 0; n < 2; ++n) {
            const LAS unsigned char* cp = cb + (cl + 4 * n) * 4;
            const f32x4 wa0 = *(const LAS f32x4*)(cp), wa1 = *(const LAS f32x4*)(cp + 512), wa2 = *(const LAS f32x4*)(cp + 1024), ba = *(const LAS f32x4*)(cp + 1536);
            const f32x4 wv0 = *(const LAS f32x4*)(cp + 2048), wv1 = *(const LAS f32x4*)(cp + 2560), wv2 = *(const LAS f32x4*)(cp + 3072), bv = *(const LAS f32x4*)(cp + 3584);
#pragma unroll
            for (int ai = 0; ai < 2; ++ai) {
                asm volatile("" ::: "memory"); __builtin_amdgcn_sched_barrier(0);
                f32x4 ha1 = {0.f, 0.f, 0.f, 0.f}, ha2 = ha1, hv1 = ha1, hv2 = ha1;
                if (fr == 0) { const LAS float* hp = halo + ((2 * ai + wr) * 2) * 256 + cl + 4 * n;
                    ha2 = *(const LAS f32x4*)hp; hv2 = *(const LAS f32x4*)(hp + 128); ha1 = *(const LAS f32x4*)(hp + 256); hv1 = *(const LAS f32x4*)(hp + 384); }
                f32x4 pa1, pa2, pv1, pv2;
#pragma unroll
                for (int c = 0; c < 4; ++c) {
                    pa1[c] = dppf<0x111, false>(ha1[c], acc[ai][0][3][n][c]); pa2[c] = dppf<0x111, false>(ha2[c], acc[ai][0][2][n][c]);
                    pv1[c] = dppf<0x111, false>(hv1[c], acc[ai][1][3][n][c]); pv2[c] = dppf<0x111, false>(hv2[c], acc[ai][1][2][n][c]);
                }
                asm volatile("" : "+v"(pa1), "+v"(pa2), "+v"(pv1), "+v"(pv2));
#pragma unroll
                for (int m = 0; m < 4; ++m) {
                    asm volatile("" : "+v"(acc[ai][0][m][n]), "+v"(acc[ai][1][m][n]), "+v"(pa1), "+v"(pv1));
                    const f32x4 ca = acc[ai][0][m][n], cv = acc[ai][1][m][n];
                    const f32x4 a = ba + wa0 * pa2 + wa1 * pa1 + wa2 * ca;
                    const f32x4 v = bv + wv0 * pv2 + wv1 * pv1 + wv2 * cv;
                    f32x4 o;
#pragma unroll
                    for (int c = 0; c < 4; ++c) o[c] = a[c] * v[c] * __builtin_amdgcn_rcpf(1.f + fexp2(-a[c] * LOG2E));
                    acc[ai][0][m][n] = o; pa2 = pa1; pv2 = pv1; pa1 = ca; pv1 = cv;
                    asm volatile("" : "+v"(acc[ai][0][m][n]));
                }
            }
        }
#pragma unroll
        for (int ai = 0; ai < 2; ++ai)
#pragma unroll
            for (int m = 0; m < 4; ++m) { const f32x4 v0 = acc[ai][0][m][0], v1 = acc[ai][0][m][1];
                u32x4 w; w.x = cvt_pk_bf16(v0[0], v0[1]); w.y = cvt_pk_bf16(v0[2], v0[3]); w.z = cvt_pk_bf16(v1[0], v1[1]); w.w = cvt_pk_bf16(v1[2], v1[3]);
                *(u32x4*)(g + (size_t)(rowb + ai * 128 + m) * DFF + ch) = w; }
    }
};

struct Epi4F {
    static constexpr bool PERM = true, PF = false, APERM = false;
    const float* base; const bf16_t* baseb; float* out; const float* gfin; float* xbuf; unsigned* cnt; LAS float* scr;
    DI void operator()(Acc& acc, const Unit& u, int wr, int wc, int fr, int fq) const {
        const int tid = threadIdx.x, lane = tid & 63;
        const int row0 = u.pm * 256 + wr * 64 + fr, col0 = u.pn * 256 + wc * 32 + 8 * fq;
        LAS float* part = scr; LAS float* S = scr + 1024;
#pragma unroll
        for (int ai = 0; ai < 2; ++ai)
#pragma unroll
            for (int m = 0; m < 4; ++m) {
                const size_t off = (size_t)(row0 + ai * 128 + m * 16) * D + col0; float s = 0.f;
#pragma unroll
                for (int bj = 0; bj < 2; ++bj) {
                    f32x4 b0, b1;
                    if (baseb) { const u32x4 rb = *(const u32x4*)(baseb + off + bj * 128); b0 = (f32x4){bflo(rb.x), bfhi(rb.x), bflo(rb.y), bfhi(rb.y)}; b1 = (f32x4){bflo(rb.z), bfhi(rb.z), bflo(rb.w), bfhi(rb.w)}; }
                    else { b0 = *(const f32x4*)(base + off + bj * 128); b1 = *(const f32x4*)(base + off + bj * 128 + 4); }
                    const f32x4 v0 = acc[ai][bj][m][0] + b0, v1 = acc[ai][bj][m][1] + b1;
                    acc[ai][bj][m][0] = v0; acc[ai][bj][m][1] = v1;
                    s += (v0[0] * v0[0] + v0[1] * v0[1]) + (v0[2] * v0[2] + v0[3] * v0[3]) + (v1[0] * v1[0] + v1[1] * v1[1]) + (v1[2] * v1[2] + v1[3] * v1[3]);
                }
                s += __shfl_xor(s, 16); s += __shfl_xor(s, 32);
                if (fq == 0) part[wc * 256 + ai * 128 + wr * 64 + m * 16 + fr] = s;
                if (m & 1) asm volatile("" ::: "memory");
            }
        asm volatile("s_waitcnt lgkmcnt(0)" ::: "memory"); __builtin_amdgcn_s_barrier(); asm volatile("" ::: "memory");
        unsigned* cw = cnt + 64 * u.pm;
        if (tid < 256) {
            const float tot = (part[tid] + part[256 + tid]) + (part[512 + tid] + part[768 + tid]);
            __hip_atomic_store(xbuf + ((size_t)u.pm * 4 + u.pn) * 256 + tid, tot, __ATOMIC_RELAXED, __HIP_MEMORY_SCOPE_AGENT);
            asm volatile("s_waitcnt vmcnt(0)" ::: "memory");
            if (lane == 0) __hip_atomic_fetch_add(cw, 1u, __ATOMIC_RELAXED, __HIP_MEMORY_SCOPE_AGENT);
        }
        if (tid == 0) {
            unsigned spins = 0;
            while (__hip_atomic_load(cw, __ATOMIC_RELAXED, __HIP_MEMORY_SCOPE_AGENT) < 16u) { __builtin_amdgcn_s_sleep(2); if (++spins > (1u << 24)) break; }
            __builtin_amdgcn_fence(__ATOMIC_ACQUIRE, "agent");
        }
        asm volatile("s_waitcnt vmcnt(0) lgkmcnt(0)" ::: "memory"); __builtin_amdgcn_s_barrier(); asm volatile("" ::: "memory");
        if (tid < 256) {
            const float* sl = xbuf + (size_t)u.pm * 4 * 256 + tid;
            const float t = (__hip_atomic_load(sl, __ATOMIC_RELAXED, __HIP_MEMORY_SCOPE_AGENT) + __hip_atomic_load(sl + 256, __ATOMIC_RELAXED, __HIP_MEMORY_SCOPE_AGENT))
                          + (__hip_atomic_load(sl + 512, __ATOMIC_RELAXED, __HIP_MEMORY_SCOPE_AGENT) + __hip_atomic_load(sl + 768, __ATOMIC_RELAXED, __HIP_MEMORY_SCOPE_AGENT));
            S[tid] = 1.0f / sqrtf(t * (1.0f / D) + EPS);
        }
        asm volatile("s_waitcnt lgkmcnt(0)" ::: "memory"); __builtin_amdgcn_s_barrier(); asm volatile("" ::: "memory");
        f32x4 gv[2][2];
#pragma unroll
        for (int bj = 0; bj < 2; ++bj) { gv[bj][0] = *(const f32x4*)(gfin + col0 + bj * 128); gv[bj][1] = *(const f32x4*)(gfin + col0 + bj * 128 + 4); }
#pragma unroll
        for (int ai = 0; ai < 2; ++ai)
#pragma unroll
            for (int m = 0; m < 4; ++m) {
                const float rs = S[ai * 128 + wr * 64 + m * 16 + fr]; const size_t off = (size_t)(row0 + ai * 128 + m * 16) * D + col0;
#pragma unroll
                for (int bj = 0; bj < 2; ++bj) { *(f32x4*)(out + off + bj * 128) = acc[ai][bj][m][0] * rs * gv[bj][0]; *(f32x4*)(out + off + bj * 128 + 4) = acc[ai][bj][m][1] * rs * gv[bj][1]; }
            }
    }
};


#define RLX_AGENT __ATOMIC_RELAXED, __HIP_MEMORY_SCOPE_AGENT
#define XB_TMO      128
#define XB_XCNT(j)  (256  + 64 * (j))
#define XB_XSUB(j)  (1280 + 64 * (j))
#define XB_XGEN(j)  (2304 + 64 * (j))
#define XB_TOP      3328
#define XB_TOPGEN   3392
#define XCD_BAR_WORDS 3456
#define XB_SPIN_CAP (1u << 18)

__device__ __forceinline__ unsigned xb_ld(unsigned* p)              { return __hip_atomic_load(p, __ATOMIC_RELAXED, __HIP_MEMORY_SCOPE_AGENT); }
__device__ __forceinline__ unsigned xb_add(unsigned* p, unsigned v) { return __hip_atomic_fetch_add(p, v, __ATOMIC_RELAXED, __HIP_MEMORY_SCOPE_AGENT); }
__device__ __forceinline__ unsigned xb_xcc_id() { return (unsigned)__builtin_amdgcn_s_getreg((3 << 11) | 20) & 0xFu; }
#define XB_SPIN(cond, bar) do { unsigned _sp = 0; while (cond) { __builtin_amdgcn_s_sleep(1); \
    if ((++_sp & 255u) == 0u) { if (xb_ld(&(bar)[XB_TMO])) break; if (_sp > XB_SPIN_CAP) { atomicAdd(&(bar)[XB_TMO], 1u); break; } } } } while (0)

struct XcdBarrier {
    unsigned* bar; unsigned x;
    volatile LAS unsigned* st;
};

__device__ __forceinline__ XcdBarrier xcd_barrier_post(unsigned* bar, volatile LAS unsigned* st) {
    XcdBarrier b; b.bar = bar; b.x = xb_xcc_id(); b.st = st;
    if (threadIdx.x == 0) (void)xb_add(&bar[XB_XCNT(b.x)], 1u);
    return b;
}
__device__ __forceinline__ void xcd_barrier_complete(unsigned* bar, unsigned x, unsigned& nloc, unsigned& nx) {
    const unsigned G = gridDim.x * gridDim.y * gridDim.z;
    unsigned sum, cnt, mine, sp = 0u;
    for (;;) {
        sum = 0u; cnt = 0u; mine = 0u;
#pragma unroll
        for (unsigned j = 0; j < 16; ++j) { const unsigned c = xb_ld(&bar[XB_XCNT(j)]); sum += c; cnt += (c > 0u) ? 1u : 0u; mine = (j == x) ? c : mine; }
        if (sum == G) break;
        __builtin_amdgcn_s_sleep(1);
        if ((++sp & 255u) == 0u) { if (xb_ld(&bar[XB_TMO])) break; if (sp > XB_SPIN_CAP) { atomicAdd(&bar[XB_TMO], 1u); break; } }
    }
    nloc = mine > 0u ? mine : 1u; nx = cnt > 0u ? cnt : 1u;
}

__device__ __forceinline__ void xcd_barrier(const XcdBarrier& b) {
    asm volatile("s_waitcnt vmcnt(0)" ::: "memory");
    __syncthreads();
    if (threadIdx.x == 0) {
        unsigned* bar = b.bar;
        __builtin_amdgcn_s_waitcnt(0);
        unsigned nloc = b.st[0], nx = b.st[1];
        if (nloc == 0u) { xcd_barrier_complete(bar, b.x, nloc, nx); b.st[0] = nloc; b.st[1] = nx; }
        const unsigned old = xb_add(&bar[XB_XSUB(b.x)], 1u);
        const unsigned gen = old / nloc;
        if (old + 1u == (gen + 1u) * nloc) {
            __builtin_amdgcn_fence(__ATOMIC_RELEASE, "agent");
            asm volatile("s_waitcnt vmcnt(0)" ::: "memory");
            const unsigned og = xb_add(&bar[XB_TOP], 1u);
            const unsigned tg = og / nx;
            if (og + 1u == (tg + 1u) * nx) xb_add(&bar[XB_TOPGEN], 1u);
            else XB_SPIN(xb_ld(&bar[XB_TOPGEN]) == tg, bar);
            __builtin_amdgcn_fence(__ATOMIC_ACQUIRE, "agent");
            xb_add(&bar[XB_XGEN(b.x)], 1u);
            asm volatile("s_waitcnt vmcnt(0)" ::: "memory");
        } else {
            XB_SPIN(xb_ld(&bar[XB_XGEN(b.x)]) == gen, bar);
            __builtin_amdgcn_fence(__ATOMIC_ACQUIRE, "agent");
            asm volatile("s_waitcnt vmcnt(0)" ::: "memory");
        }
    }
    __syncthreads();
}

struct Args {
    const float* x; const float* attn_g; const float* w_in; const float* w_gate_up; const float* b_gate_up; const float* sb_g; const float* gla_g; const float* w_out;
    const float* ffn_g; const float* w_up; const float* conv_w; const float* conv_b; const float* w_down; const float* final_g;
    float* out; unsigned char* ws; int ph_lo, ph_hi, coop, pad;
};

DI void tr_item(const float* src, int ldsrc, const float* gain, float cscale, bf16_t* dst, int lddst, LAS float* scr, int lane) {
    {
        const f32x4* sp = (const f32x4*)(src + (size_t)lane * ldsrc); const float gs = gain ? gain[lane] * cscale : cscale;
        f32x4 v[8];
#pragma unroll
        for (int j = 0; j < 8; ++j) v[j] = sp[j];
#pragma unroll
        for (int j = 0; j < 8; ++j)
#pragma unroll
            for (int e = 0; e < 4; ++e) scr[lane * 33 + 4 * j + e] = v[j][e] * gs;
    }
    asm volatile("s_waitcnt lgkmcnt(0)" ::: "memory");
    const int c = lane & 7;
#pragma unroll
    for (int j = 0; j < 4; ++j) { const int n = (lane >> 3) + 8 * j; const LAS float* s = scr + (8 * c) * 33 + n;
        u32x4 o; o.x = cvt_pk_bf16(s[0 * 33], s[1 * 33]); o.y = cvt_pk_bf16(s[2 * 33], s[3 * 33]); o.z = cvt_pk_bf16(s[4 * 33], s[5 * 33]); o.w = cvt_pk_bf16(s[6 * 33], s[7 * 33]);
        *(u32x4*)(dst + (size_t)n * lddst + 8 * c) = o; }
    asm volatile("s_waitcnt lgkmcnt(0)" ::: "memory");
}
DI void phase_prep(const Args& a, LAS unsigned char* lds) {
    const int tid = threadIdx.x, lane = tid & 63, wave = tid >> 6;
    const int gw = blockIdx.x * 8 + wave, NGW = gridDim.x * 8;
    LAS float* scr = (LAS float*)(lds + wave * 16384);
    bf16_t* Win = (bf16_t*)(a.ws + WS_WIN); bf16_t* Wout = (bf16_t*)(a.ws + WS_WOUT); bf16_t* Wup = (bf16_t*)(a.ws + WS_WUP); bf16_t* Wdn = (bf16_t*)(a.ws + WS_WDN);
    constexpr int I_IN = 16 * 96, I_OUT = 16 * 32, I_UP = 16 * 176, I_DN = 44 * 32, NIT = I_IN + I_OUT + I_UP + I_DN;
    for (int it = gw; it < NIT; it += NGW) {
        int r = it;
        if (r < I_IN) { const int kb = r / 96, nb = r % 96, k0 = 64 * kb, n0 = 32 * nb, c0 = n0 < 2560 ? n0 : n0 + 16;
            tr_item(a.w_in + (size_t)k0 * 3088 + c0, 3088, a.attn_g + k0, n0 < 512 ? QSCALE : 1.0f, Win + (size_t)n0 * D + k0, D, scr, lane); continue; }
        r -= I_IN;
        if (r < I_OUT) { const int kb = r / 32, nb = r % 32, k0 = 64 * kb, n0 = 32 * nb;
            tr_item(a.w_out + (size_t)k0 * D + n0, D, nullptr, 1.0f, Wout + (size_t)n0 * D + k0, D, scr, lane); continue; }
        r -= I_OUT;
        if (r < I_UP) { const int kb = r / 176, nb = r % 176, k0 = 64 * kb, n0 = 32 * nb, j = n0 >> 8, w = n0 & 255, c0 = w < 128 ? 128 * j + w : DFF + 128 * j + (w - 128);
            tr_item(a.w_up + (size_t)k0 * NU + c0, NU, a.ffn_g + k0, 1.0f, Wup + (size_t)n0 * D + k0, D, scr, lane); continue; }
        r -= I_UP;
        { const int kb = r / 32, nb = r % 32, k0 = 64 * kb, n0 = 32 * nb;
            tr_item(a.w_down + (size_t)k0 * D + n0, D, nullptr, 1.0f, Wdn + (size_t)n0 * DFF + k0, DFF, scr, lane); }
    }
    for (int it = blockIdx.x * 512 + tid; it < 256 * 128; it += gridDim.x * 512) {
        const int n = it >> 7, k0 = (it & 127) * 8;
        float wg[16];
#pragma unroll
        for (int r = 0; r < 16; ++r) wg[r] = a.w_gate_up[r * 256 + n];
        float o[8];
#pragma unroll
        for (int kk = 0; kk < 8; ++kk) { const float* wr_ = a.w_in + (size_t)(k0 + kk) * 3088 + 2560; float s = 0.f;
#pragma unroll
            for (int r4 = 0; r4 < 4; ++r4) { const f32x4 w4 = *(const f32x4*)(wr_ + 4 * r4); s += w4[0] * wg[4 * r4] + w4[1] * wg[4 * r4 + 1] + w4[2] * wg[4 * r4 + 2] + w4[3] * wg[4 * r4 + 3]; }
            o[kk] = s * a.attn_g[k0 + kk]; }
        u32x4 w; w.x = cvt_pk_bf16(o[0], o[1]); w.y = cvt_pk_bf16(o[2], o[3]); w.z = cvt_pk_bf16(o[4], o[5]); w.w = cvt_pk_bf16(o[6], o[7]);
        *(u32x4*)(Win + (size_t)(3072 + n) * D + k0) = w;
    }
    for (int it = gw; it < 2048; it += NGW) {
        const int kp = it & 7, cgp = (it >> 3) & 7, b = it >> 6, col = (cgp < 4 ? 1536 + 64 * cgp : 1792 + 64 * (cgp - 4)) + lane;
        const float* xr = a.x + (size_t)b * SEQ * D + 128 * kp; const float* gr = a.attn_g + 128 * kp; const float* wr_ = a.w_in + (size_t)(128 * kp) * 3088 + col;
        float s0 = 0.f, s1 = 0.f, s2 = 0.f, s3 = 0.f;
#pragma unroll 8
        for (int k = 0; k < 128; k += 4) {
            s0 += xr[k] * gr[k] * wr_[(size_t)k * 3088];
            s1 += xr[k + 1] * gr[k + 1] * wr_[(size_t)(k + 1) * 3088];
            s2 += xr[k + 2] * gr[k + 2] * wr_[(size_t)(k + 2) * 3088];
            s3 += xr[k + 3] * gr[k + 3] * wr_[(size_t)(k + 3) * 3088];
        }
        ((float*)(a.ws + WS_QK0))[(kp * 32 + b) * 512 + cgp * 64 + lane] = (s0 + s1) + (s2 + s3);
    }
    bf16_t* xb = (bf16_t*)(a.ws + WS_XB); float* rstd1 = (float*)(a.ws + WS_RSTD1);
    for (int m = gw; m < T; m += NGW) {
        const f32x4* xr = (const f32x4*)(a.x + (size_t)m * D) + lane; f32x4 v[4]; float s = 0.f;
#pragma unroll
        for (int j = 0; j < 4; ++j) { v[j] = __builtin_nontemporal_load(&xr[64 * j]); s += (v[j][0] * v[j][0] + v[j][1] * v[j][1]) + (v[j][2] * v[j][2] + v[j][3] * v[j][3]); }
        s = wave_sum(s);
        if (lane == 0) rstd1[m] = 1.0f / sqrtf(s * (1.0f / D) + EPS);
        u32x2* o8 = (u32x2*)(xb + (size_t)m * D) + lane;
#pragma unroll
        for (int j = 0; j < 4; ++j) { u32x2 w; w.x = cvt_pk_bf16(v[j][0], v[j][1]); w.y = cvt_pk_bf16(v[j][2], v[j][3]); o8[64 * j] = w; }
    }
}

#ifndef USE_TR
#define USE_TR 1
#endif
DI s16x4 gather4(const LAS unsigned char* base, int pitchB, int row0, int cbase, int lane) {
#if USE_TR
    const int i = lane & 15;
    const LAS unsigned char* p = base + (row0 + (i >> 2)) * pitchB + (cbase + 4 * (i & 3)) * 2;
    return __builtin_amdgcn_ds_read_tr16_b64_v4i16((LAS s16x4*)p);
#else
    const LAS unsigned char* p = base + row0 * pitchB + (cbase + (lane & 15)) * 2;
    s16x4 r;
    r[0] = *(const LAS short*)(p); r[1] = *(const LAS short*)(p + pitchB); r[2] = *(const LAS short*)(p + 2 * pitchB); r[3] = *(const LAS short*)(p + 3 * pitchB);
    return r;
#endif
}
DI bf16x8 cat8(s16x4 lo, s16x4 hi) { return __builtin_shufflevector(lo, hi, 0, 1, 2, 3, 4, 5, 6, 7); }
DI bf16x8 pack8(float a0, float a1, float a2, float a3, float a4, float a5, float a6, float a7) {
    u32x4 w; w.x = cvt_pk_bf16(a0, a1); w.y = cvt_pk_bf16(a2, a3); w.z = cvt_pk_bf16(a4, a5); w.w = cvt_pk_bf16(a6, a7); return __builtin_bit_cast(bf16x8, w);
}

constexpr float SB_CUT = 5.421010862427522e-20f;
constexpr int VPITCH = 144;
DI void sb_wave(const bf16_t* proj, bf16_t* ocat, const float* sbg, int b, int h, int q0, LAS unsigned char* vl, int lane) {
    const int r32 = lane & 31, h2 = lane >> 5;
    const size_t rowbase = (size_t)b * SEQ;
    bf16x8 qf[4];
    { const bf16_t* qp = proj + (rowbase + q0 + r32) * PP + Q_OFF + h * 64 + 8 * h2;
#pragma unroll
      for (int s = 0; s < 4; ++s) qf[s] = *(const bf16x8*)(qp + 16 * s); }
    f32x4 gsb[2][4];
#pragma unroll
    for (int dt = 0; dt < 2; ++dt)
#pragma unroll
        for (int gi = 0; gi < 4; ++gi) gsb[dt][gi] = *(const f32x4*)(sbg + h * 64 + 32 * dt + 8 * gi + 4 * h2);
    f32x16 o0, o1;
#pragma unroll
    for (int r = 0; r < 16; ++r) { o0[r] = 0.f; o1[r] = 0.f; }
    float carry = 1.f;
    const int grp = (lane >> 4) & 1;
    bf16x8 kn[4]; u32x4 vn0, vn1, vn2, vn3;
    { const int k0 = q0;
      const bf16_t* kp = proj + (rowbase + k0 + r32) * PP + K_OFF + h * 64 + 8 * h2;
#pragma unroll
      for (int s = 0; s < 4; ++s) kn[s] = *(const bf16x8*)(kp + 16 * s);
      const bf16_t* vp = proj + (rowbase + k0 + (lane >> 1)) * PP + V_OFF + h * 64 + 32 * (lane & 1);
      vn0 = *(const u32x4*)(vp); vn1 = *(const u32x4*)(vp + 8); vn2 = *(const u32x4*)(vp + 16); vn3 = *(const u32x4*)(vp + 24); }
    for (int kt = q0 >> 5; kt >= 0; --kt) {
        const int k0 = kt * 32; const bool diag = (k0 == q0);
        bf16x8 kf[4];
#pragma unroll
        for (int s = 0; s < 4; ++s) kf[s] = kn[s];
        { LAS unsigned char* dp = vl + (lane >> 1) * VPITCH + 64 * (lane & 1);
          *(LAS u32x4*)(dp) = vn0; *(LAS u32x4*)(dp + 16) = vn1; *(LAS u32x4*)(dp + 32) = vn2; *(LAS u32x4*)(dp + 48) = vn3; }
        if (kt > 0) {
            const int k1 = k0 - 32;
            const bf16_t* kp = proj + (rowbase + k1 + r32) * PP + K_OFF + h * 64 + 8 * h2;
#pragma unroll
            for (int s = 0; s < 4; ++s) kn[s] = *(const bf16x8*)(kp + 16 * s);
            const bf16_t* vp = proj + (rowbase + k1 + (lane >> 1)) * PP + V_OFF + h * 64 + 32 * (lane & 1);
            vn0 = *(const u32x4*)(vp); vn1 = *(const u32x4*)(vp + 8); vn2 = *(const u32x4*)(vp + 16); vn3 = *(const u32x4*)(vp + 24);
        }
        f32x16 z;
#pragma unroll
        for (int r = 0; r < 16; ++r) z[r] = 0.f;
#pragma unroll
        for (int s = 0; s < 4; ++s) z = __builtin_amdgcn_mfma_f32_32x32x16_bf16(kf[s], qf[s], z, 0, 0, 0);
        float om[16], be[16];
#pragma unroll
        for (int r = 0; r < 16; ++r) {
            const float e = fexp2(fminf(z[r], 80.f)); const float rc = __builtin_amdgcn_rcpf(1.f + e);
            float b_ = e * rc, o_ = rc;
            if (diag) { const int kvl = (r & 3) + 8 * (r >> 2) + 4 * h2; if (kvl >= r32) { b_ = 0.f; o_ = 1.f; } }
            be[r] = b_; om[r] = o_;
        }
        float sg[4], ps[4];
#pragma unroll
        for (int gi = 0; gi < 4; ++gi) { sg[gi] = (om[4 * gi] * om[4 * gi + 1]) * (om[4 * gi + 2] * om[4 * gi + 3]); ps[gi] = __shfl_xor(sg[gi], 32); }
        float e[4]; float run = 1.f;
#pragma unroll
        for (int gi = 3; gi >= 0; --gi) {
            const float hi = h2 ? sg[gi] : ps[gi], lo = h2 ? ps[gi] : sg[gi];
            const float e_hi = run; run *= hi; const float e_lo = run; run *= lo;
            e[gi] = h2 ? e_hi : e_lo;
        }
        float w[16];
#pragma unroll
        for (int gi = 0; gi < 4; ++gi) {
            float A = carry * e[gi];
#pragma unroll
            for (int j = 3; j >= 0; --j) { const int r = 4 * gi + j; w[r] = be[r] * A; A *= om[r]; }
        }
        carry *= run;
        asm volatile("s_waitcnt lgkmcnt(0)" ::: "memory");
#pragma unroll
        for (int s = 0; s < 2; ++s) {
            const bf16x8 pf = pack8(w[8 * s], w[8 * s + 1], w[8 * s + 2], w[8 * s + 3], w[8 * s + 4], w[8 * s + 5], w[8 * s + 6], w[8 * s + 7]);
            const bf16x8 va = cat8(gather4(vl, VPITCH, 16 * s + 4 * h2, 16 * grp, lane), gather4(vl, VPITCH, 16 * s + 8 + 4 * h2, 16 * grp, lane));
            const bf16x8 vb = cat8(gather4(vl, VPITCH, 16 * s + 4 * h2, 32 + 16 * grp, lane), gather4(vl, VPITCH, 16 * s + 8 + 4 * h2, 32 + 16 * grp, lane));
            o0 = __builtin_amdgcn_mfma_f32_32x32x16_bf16(va, pf, o0, 0, 0, 0);
            o1 = __builtin_amdgcn_mfma_f32_32x32x16_bf16(vb, pf, o1, 0, 0, 0);
        }
        asm volatile("s_waitcnt lgkmcnt(0)" ::: "memory");
        if (__all(carry < SB_CUT)) break;
    }
    float ss = 0.f;
#pragma unroll
    for (int r = 0; r < 16; ++r) ss += o0[r] * o0[r] + o1[r] * o1[r];
    ss += __shfl_xor(ss, 32);
    const float rs = 1.0f / sqrtf(ss * (1.0f / 64.0f) + EPS);
    bf16_t* op = ocat + (rowbase + q0 + r32) * D + h * 64;
#pragma unroll
    for (int dt = 0; dt < 2; ++dt)
#pragma unroll
        for (int gi = 0; gi < 4; ++gi) {
            const int d = 32 * dt + 8 * gi + 4 * h2; const f32x4 gg = gsb[dt][gi];
            const f32x16& o = dt ? o1 : o0;
            u32x2 wv; wv.x = cvt_pk_bf16(o[4 * gi] * rs * gg[0], o[4 * gi + 1] * rs * gg[1]); wv.y = cvt_pk_bf16(o[4 * gi + 2] * rs * gg[2], o[4 * gi + 3] * rs * gg[3]);
            *(u32x2*)(op + d) = wv;
        }
}

constexpr int GP = 144, GVP = 272;
constexpr int G_QD = 0, G_KI = 64 * GP, G_V = 2 * 64 * GP, G_DEC = G_V + 64 * GVP, G_BUF = 36352, G_SSQ = 2 * G_BUF, G_END = G_SSQ + 2 * 8 * 64 * 4;
static_assert(G_DEC + 256 <= G_BUF && G_END <= GEMM_LDS, "GLA LDS map");
DI void gla_unit(const Args& a, int b, int h, LAS unsigned char* lds) {
    const int tid = threadIdx.x, lane = tid & 63, w = tid >> 6, c = lane & 15, g = lane >> 4;
    const bf16_t* proj = (const bf16_t*)(a.ws + WS_PROJ); const float* b2 = (const float*)(a.ws + WS_B2); bf16_t* ocat = (bf16_t*)(a.ws + WS_OCAT);
    const size_t rowbase = (size_t)b * SEQ;
    f32x4 S[4];
#pragma unroll
    for (int dt = 0; dt < 4; ++dt) S[dt] = (f32x4){0.f, 0.f, 0.f, 0.f};
    const int si = tid >> 3, sc8 = (tid & 7) * 8, sv16 = (tid & 7) * 16;
    float s00;
    {
        const float* qk0 = (const float*)(a.ws + WS_QK0) + b * 512;
        const float rs1 = ((const float*)(a.ws + WS_RSTD1))[rowbase];
        float q0 = 0.f, k0 = 0.f;
#pragma unroll
        for (int kp = 0; kp < 8; ++kp) { q0 += qk0[kp * 32 * 512 + h * 64 + lane]; k0 += qk0[kp * 32 * 512 + 256 + h * 64 + lane]; }
        s00 = wave_sum(q0 * k0) * rs1 * rs1 * 0.125f;
    }
    u32x4 pqv, pkv, pv0, pv1; f32x4 pba, pbb; u32x2 pog[4];
#define GLA_LOAD(nn) do { const size_t t0_ = rowbase + 64 * (nn), row_ = t0_ + si; \
        pqv = *(const u32x4*)(proj + row_ * PP + GQ_OFF + h * 64 + sc8); pkv = *(const u32x4*)(proj + row_ * PP + GK_OFF + h * 64 + sc8); \
        pba = *(const f32x4*)(b2 + row_ * 256 + h * 64 + sc8); pbb = *(const f32x4*)(b2 + row_ * 256 + h * 64 + sc8 + 4); \
        pv0 = *(const u32x4*)(proj + row_ * PP + GV_OFF + h * 128 + sv16); pv1 = *(const u32x4*)(proj + row_ * PP + GV_OFF + h * 128 + sv16 + 8); \
        _Pragma("unroll") for (int it_ = 0; it_ < 4; ++it_) pog[it_] = *(const u32x2*)(proj + (t0_ + 16 * it_ + c) * PP + OG_OFF + h * 128 + 16 * w + 4 * g); } while (0)
#define GLA_FINAL(nn, OV, SV) do { const size_t t0_ = rowbase + 64 * (nn); const LAS float* sq_ = (const LAS float*)(lds + G_SSQ + ((nn) & 1) * 2048); \
        _Pragma("unroll") for (int it = 0; it < 4; ++it) { const int i = 16 * it + c; float tot = 0.f; \
            _Pragma("unroll") for (int ww = 0; ww < 8; ++ww) tot += sq_[ww * 64 + i]; \
            const float rs = __builtin_amdgcn_rsqf(tot * (1.0f / 128.0f) + EPS); \
            u32x2 wv; wv.x = cvt_pk_bf16(OV[it][0] * rs * SV[it][0], OV[it][1] * rs * SV[it][1]); wv.y = cvt_pk_bf16(OV[it][2] * rs * SV[it][2], OV[it][3] * rs * SV[it][3]); \
            *(u32x2*)(ocat + (t0_ + i) * D + 512 + h * 128 + 16 * w + 4 * g) = wv; } } while (0)
    GLA_LOAD(0);
    f32x4 o_prev[4], sil_prev[4];
#pragma unroll
    for (int it = 0; it < 4; ++it) { o_prev[it] = (f32x4){0.f, 0.f, 0.f, 0.f}; sil_prev[it] = o_prev[it]; }
    for (int n = 0; n < 32; ++n) {
        LAS unsigned char* bl_ = lds + (n & 1) * G_BUF;
        f32x4 sil[4];
        {
            const u32x4 qv = pqv, kv = pkv; const f32x4 ba = pba, bb = pbb; const u32x4 v0 = pv0, v1 = pv1;
#pragma unroll
            for (int it = 0; it < 4; ++it) sil[it] = (f32x4){bflo(pog[it].x), bfhi(pog[it].x), bflo(pog[it].y), bfhi(pog[it].y)};
            asm volatile("" : "+v"(sil[0]), "+v"(sil[1]), "+v"(sil[2]), "+v"(sil[3]));
            float qd[8], ki[8];
#pragma unroll
            for (int j = 0; j < 4; ++j) {
                const unsigned qw = qv[j], kw = kv[j];
                const float bl = (2 * j < 4) ? ba[2 * j] : bb[2 * j - 4], bh = (2 * j + 1 < 4) ? ba[2 * j + 1] : bb[2 * j + 1 - 4];
                qd[2 * j] = bflo(qw) * 0.125f * fexp2(bl); qd[2 * j + 1] = bfhi(qw) * 0.125f * fexp2(bh);
                ki[2 * j] = bflo(kw) * fexp2(-bl);         ki[2 * j + 1] = bfhi(kw) * fexp2(-bh);
            }
            *(LAS bf16x8*)(bl_ + G_QD + si * GP + sc8 * 2) = pack8(qd[0], qd[1], qd[2], qd[3], qd[4], qd[5], qd[6], qd[7]);
            *(LAS bf16x8*)(bl_ + G_KI + si * GP + sc8 * 2) = pack8(ki[0], ki[1], ki[2], ki[3], ki[4], ki[5], ki[6], ki[7]);
            *(LAS u32x4*)(bl_ + G_V + si * GVP + sv16 * 2) = v0; *(LAS u32x4*)(bl_ + G_V + si * GVP + sv16 * 2 + 16) = v1;
            if (si == 63) { LAS float* dp = (LAS float*)(bl_ + G_DEC) + sc8;
#pragma unroll
                for (int j = 0; j < 4; ++j) { dp[j] = fexp2(ba[j]); dp[4 + j] = fexp2(bb[j]); } }
        }
        if (n + 1 < 32) GLA_LOAD(n + 1);
        asm volatile("s_waitcnt lgkmcnt(0)" ::: "memory"); __builtin_amdgcn_s_barrier(); asm volatile("" ::: "memory");
        if (n > 0) GLA_FINAL(n - 1, o_prev, sil_prev);
        bf16x8 vT[2], Sb[2];
#pragma unroll
        for (int s = 0; s < 2; ++s) {
            vT[s] = cat8(gather4(bl_ + G_V, GVP, 32 * s + 4 * g, 16 * w, lane), gather4(bl_ + G_V, GVP, 32 * s + 16 + 4 * g, 16 * w, lane));
            Sb[s] = pack8(S[2 * s][0], S[2 * s][1], S[2 * s][2], S[2 * s][3], S[2 * s + 1][0], S[2 * s + 1][1], S[2 * s + 1][2], S[2 * s + 1][3]);
        }
        f32x4 o[4];
#pragma unroll
        for (int it = 0; it < 4; ++it) {
            const LAS unsigned char* qrow = bl_ + G_QD + (16 * it + c) * GP;
            const bf16x8 qn0 = *(const LAS bf16x8*)(qrow + 16 * g), qn1 = *(const LAS bf16x8*)(qrow + 64 + 16 * g);
            f32x4 P[4];
#pragma unroll
            for (int jt = 0; jt < 4; ++jt) {
                P[jt] = (f32x4){0.f, 0.f, 0.f, 0.f};
                if (jt <= it) {
                    const LAS unsigned char* krow = bl_ + G_KI + (16 * jt + c) * GP;
                    const bf16x8 k0 = *(const LAS bf16x8*)(krow + 16 * g), k1 = *(const LAS bf16x8*)(krow + 64 + 16 * g);
                    P[jt] = __builtin_amdgcn_mfma_f32_16x16x32_bf16(k0, qn0, P[jt], 0, 0, 0);
                    P[jt] = __builtin_amdgcn_mfma_f32_16x16x32_bf16(k1, qn1, P[jt], 0, 0, 0);
                    if (jt == it) {
#pragma unroll
                        for (int r = 0; r < 4; ++r) if (4 * g + r > c) P[jt][r] = 0.f;
                        if (it == 0 && n == 0 && lane == 0) P[jt][0] = s00;
                    }
                }
            }
            f32x4 acc = {0.f, 0.f, 0.f, 0.f};
            { const bf16x8 pb = pack8(P[0][0], P[0][1], P[0][2], P[0][3], P[1][0], P[1][1], P[1][2], P[1][3]);
              acc = __builtin_amdgcn_mfma_f32_16x16x32_bf16(vT[0], pb, acc, 0, 0, 0); }
            if (it >= 2) { const bf16x8 pb = pack8(P[2][0], P[2][1], P[2][2], P[2][3], P[3][0], P[3][1], P[3][2], P[3][3]);
              acc = __builtin_amdgcn_mfma_f32_16x16x32_bf16(vT[1], pb, acc, 0, 0, 0); }
#pragma unroll
            for (int s = 0; s < 2; ++s) {
                const s16x4 qa = *(const LAS s16x4*)(qrow + (32 * s + 4 * g) * 2), qb = *(const LAS s16x4*)(qrow + (32 * s + 16 + 4 * g) * 2);
                acc = __builtin_amdgcn_mfma_f32_16x16x32_bf16(Sb[s], cat8(qa, qb), acc, 0, 0, 0);
            }
            o[it] = acc;
        }
#pragma unroll
        for (int dt = 0; dt < 4; ++dt) {
            const f32x4 dec = *(const LAS f32x4*)(bl_ + G_DEC + (16 * dt + 4 * g) * 4);
            f32x4 sacc = S[dt];
#pragma unroll
            for (int s = 0; s < 2; ++s) {
                const bf16x8 ka = cat8(gather4(bl_ + G_KI, GP, 32 * s + 4 * g, 16 * dt, lane), gather4(bl_ + G_KI, GP, 32 * s + 16 + 4 * g, 16 * dt, lane));
                sacc = __builtin_amdgcn_mfma_f32_16x16x32_bf16(ka, vT[s], sacc, 0, 0, 0);
            }
            S[dt] = sacc * dec;
        }
        { LAS float* sq = (LAS float*)(lds + G_SSQ + (n & 1) * 2048);
#pragma unroll
          for (int it = 0; it < 4; ++it) {
            float s = (o[it][0] * o[it][0] + o[it][1] * o[it][1]) + (o[it][2] * o[it][2] + o[it][3] * o[it][3]);
            s += __shfl_xor(s, 16); s += __shfl_xor(s, 32);
            if (g == 0) sq[w * 64 + 16 * it + c] = s;
            o_prev[it] = o[it]; sil_prev[it] = sil[it];
          } }
    }
    asm volatile("s_waitcnt lgkmcnt(0)" ::: "memory"); __builtin_amdgcn_s_barrier(); asm volatile("" ::: "memory");
    GLA_FINAL(31, o_prev, sil_prev);
#undef GLA_LOAD
#undef GLA_FINAL
    __syncthreads();
}

DI void phase_mix(const Args& a, LAS unsigned char* lds, int cidx = 0, int mode = 0) {
    const int tid = threadIdx.x, lane = tid & 63, w = tid >> 6;
    unsigned* ctr = (unsigned*)(a.ws + WS_CTL) + 64 * cidx;
    volatile LAS unsigned* sh = (volatile LAS unsigned*)(lds + MISC_OFF);
    constexpr int NGLA = NB * 4, NSB = NB * 8 * 8, NUNIT = NGLA + NSB;
    unsigned nxt = 0;
    if (tid == 0) nxt = atomicAdd(ctr, 1u);
    for (;;) {
        if (tid == 0) sh[0] = nxt;
        __syncthreads();
        const int u = (int)sh[0];
        __syncthreads();
        if (u >= NUNIT) break;
        if (tid == 0) nxt = atomicAdd(ctr, 1u);
        if (u < NGLA) { if (mode != 1) gla_unit(a, u >> 2, u & 3, lds); }
        else if (mode != 2) {
            const int v = u - NGLA, bh = v >> 3, qb = 7 - (v & 7);
            sb_wave((const bf16_t*)(a.ws + WS_PROJ), (bf16_t*)(a.ws + WS_OCAT), a.sb_g, bh >> 3, bh & 7, qb * 256 + 32 * w, lds + w * 8192, lane);
        }
    }
}

DI void phase_fix(const Args& a) {
    const float* hh = (const float*)(a.ws + WS_HHEAD); const float* ht = (const float*)(a.ws + WS_HTAIL); bf16_t* g = (bf16_t*)(a.ws + WS_G);
    constexpr int PER = 2 * 704;
    for (int it = blockIdx.x * 512 + threadIdx.x; it < 256 * PER; it += gridDim.x * 512) {
        const int pm = it / PER, rem = it % PER, rr = rem / 704, ch = (rem % 704) * 4;
        if ((pm & 7) == 0) continue;
        const int j = ch >> 7, wv = ch & 127, pa = 256 * j + wv, pv = pa + 128;
        const float* t0 = ht + ((size_t)(pm - 1) * 2) * NU; const float* t1 = t0 + NU; const float* h0 = hh + ((size_t)pm * 2) * NU; const float* h1 = h0 + NU;
        const float *m2 = rr == 0 ? t0 : t1, *m1 = rr == 0 ? t1 : h0, *m0 = rr == 0 ? h0 : h1;
        const f32x4 a2 = *(const f32x4*)(m2 + pa), a1 = *(const f32x4*)(m1 + pa), a0 = *(const f32x4*)(m0 + pa);
        const f32x4 v2 = *(const f32x4*)(m2 + pv), v1 = *(const f32x4*)(m1 + pv), v0 = *(const f32x4*)(m0 + pv);
        const f32x4 wa0 = *(const f32x4*)(a.conv_w + ch), wa1 = *(const f32x4*)(a.conv_w + NU + ch), wa2 = *(const f32x4*)(a.conv_w + 2 * NU + ch), ba = *(const f32x4*)(a.conv_b + ch);
        const f32x4 wv0 = *(const f32x4*)(a.conv_w + DFF + ch), wv1 = *(const f32x4*)(a.conv_w + NU + DFF + ch), wv2 = *(const f32x4*)(a.conv_w + 2 * NU + DFF + ch), bv = *(const f32x4*)(a.conv_b + DFF + ch);
        const f32x4 av = ba + wa0 * a2 + wa1 * a1 + wa2 * a0, vv = bv + wv0 * v2 + wv1 * v1 + wv2 * v0;
        float o[4];
#pragma unroll
        for (int c = 0; c < 4; ++c) o[c] = av[c] * vv[c] * __builtin_amdgcn_rcpf(1.f + fexp2(-av[c] * LOG2E));
        u32x2 w; w.x = cvt_pk_bf16(o[0], o[1]); w.y = cvt_pk_bf16(o[2], o[3]);
        *(u32x2*)(g + (size_t)(pm * 256 + rr) * DFF + ch) = w;
    }
}

DI void phase_final(const Args& a) {
    const int lane = threadIdx.x & 63, gw = blockIdx.x * 8 + (threadIdx.x >> 6), NGW = gridDim.x * 8;
    const float* ssq3 = (const float*)(a.ws + WS_SSQ3);
    f32x4 gv[4];
#pragma unroll
    for (int j = 0; j < 4; ++j) gv[j] = ((const f32x4*)a.final_g)[lane + 64 * j];
    for (int m = gw; m < T; m += NGW) {
        const float rs = 1.0f / sqrtf(ssq3[m] * (1.0f / D) + EPS);
        f32x4* xr = (f32x4*)(a.out + (size_t)m * D) + lane;
#pragma unroll
        for (int j = 0; j < 4; ++j) { const f32x4 v = xr[64 * j]; xr[64 * j] = v * rs * gv[j]; }
    }
}

__global__ void __launch_bounds__(512, 2) fwd(Args a) {
    extern __shared__ __attribute__((aligned(16))) unsigned char smem[];
    LAS unsigned char* lds = (LAS unsigned char*)smem;
    const int lo = a.ph_lo, hi = a.ph_hi;
    const int G = gridDim.x, cu = blockIdx.x;
#ifndef PH_MASK
#define PH_MASK 255
#endif
#define IN(k) (((PH_MASK >> (k)) & 1) && lo <= (k) && (k) < hi)
    volatile LAS unsigned* MISC = (volatile LAS unsigned*)(lds + MISC_OFF);
    if (threadIdx.x < 16) MISC[threadIdx.x] = 0u;
    __syncthreads();
    XcdBarrier xbar; xbar.bar = (unsigned*)(a.ws + WS_CTL) + 24576; xbar.x = 0; xbar.st = nullptr;
    if (a.coop) xbar = xcd_barrier_post((unsigned*)(a.ws + WS_CTL) + 24576, MISC + 8);
    if (a.pad == 0x7eadbeef) cg::this_grid().sync();
#define SEAM(k) do { if (a.coop && IN(k) && IN((k) + 1)) { xcd_barrier(xbar); } } while (0)
    if (IN(0)) { phase_prep(a, lds);
#ifdef PROBE_P0
        cg::this_grid().sync(); phase_prep(a, lds);
#endif
#ifdef PROBE_SYNC4
#endif
    }
    SEAM(0);
#ifdef CODE_PAD
    asm volatile(".rept " CODE_PAD_STR "\n\ts_nop 0\n\t.endr" ::: "memory");
#endif
#ifdef PROBE_SYNC4
    xcd_barrier(xbar); xcd_barrier(xbar); xcd_barrier(xbar); xcd_barrier(xbar);
#endif
    if (IN(1)) {
        pg8::Gemm g{(const bf16_t*)(a.ws + WS_XB), (const bf16_t*)(a.ws + WS_WIN), T, N1, D}; pg8::StaticOrder S; S.init(T, N1, G, cu);
        Epi1 E{(bf16_t*)(a.ws + WS_PROJ), (float*)(a.ws + WS_B2), (const float*)(a.ws + WS_RSTD1), a.b_gate_up, a.gla_g};
        pg8::gemm_phase<Epi1, pg8::StaticOrder>(lds, g, S, E);
#ifdef PROBE_G1
        cg::this_grid().sync(); pg8::gemm_phase<Epi1, pg8::StaticOrder>(lds, g, S, E);
#endif
    }
    SEAM(1);
    if (IN(2)) { phase_mix(a, lds);
#ifdef PROBE_MIX2
        cg::this_grid().sync(); phase_mix(a, lds, 1, PROBE_MIX2);
#endif
    }
    SEAM(2);
    if (IN(3)) {
        pg8::Gemm g{(const bf16_t*)(a.ws + WS_OCAT), (const bf16_t*)(a.ws + WS_WOUT), T, D, D}; pg8::StaticOrder S; S.init(T, D, G, cu);
        EpiRes<true> E{a.x, ((G == 256) && a.coop) ? nullptr : a.out, (bf16_t*)(a.ws + WS_XB), (float*)(a.ws + WS_SSQ2), ((G == 256) && a.coop) ? (const bf16_t*)(a.ws + WS_XB) : nullptr};
        pg8::gemm_phase<EpiRes<true>, pg8::StaticOrder>(lds, g, S, E);
    }
    SEAM(3);
    if (IN(4)) {
        pg8::Gemm g{(const bf16_t*)(a.ws + WS_XB), (const bf16_t*)(a.ws + WS_WUP), T, NU, D}; pg8::StaticOrder S; S.init(T, NU, G, cu);
        Epi3 E{(bf16_t*)(a.ws + WS_G), (const float*)(a.ws + WS_SSQ2), a.conv_w, a.conv_b, (float*)(a.ws + WS_HHEAD), (float*)(a.ws + WS_HTAIL), (LAS float*)(lds + HALO_OFF), lds + PF_OFF};
        pg8::gemm_phase<Epi3, pg8::StaticOrder>(lds, g, S, E);
#ifdef PROBE_G3
        cg::this_grid().sync(); pg8::gemm_phase<Epi3, pg8::StaticOrder>(lds, g, S, E);
#endif
    }
    SEAM(4);
    if (IN(5)) { phase_fix(a); }
    SEAM(5);
    const bool fused_final = (G == 256) && a.coop;
    if (IN(6)) {
        pg8::Gemm g{(const bf16_t*)(a.ws + WS_G), (const bf16_t*)(a.ws + WS_WDN), T, D, DFF}; pg8::StaticOrder S; S.init(T, D, G, cu, 1);
        if (fused_final) {
            Epi4F E{a.out, (const bf16_t*)(a.ws + WS_XB), a.out, a.final_g, (float*)(a.ws + WS_XCH), (unsigned*)(a.ws + WS_CTL) + 4096, (LAS float*)(lds + HALO_OFF)};
            pg8::gemm_phase<Epi4F, pg8::StaticOrder>(lds, g, S, E);
        } else {
            EpiRes<false> E{a.out, a.out, nullptr, (float*)(a.ws + WS_SSQ3), nullptr};
            pg8::gemm_phase<EpiRes<false>, pg8::StaticOrder>(lds, g, S, E);
        }
    }
    if (!fused_final) {
        SEAM(6);
        if (IN(7)) { phase_final(a); }
    }
#undef IN
#undef SEAM
}

#ifndef ONE_LAUNCH
#define ONE_LAUNCH 1
#endif
extern "C" void kernel_launch(void* const* d_in, const int* in_sizes, int n_in, void* d_out, int out_size, void* d_ws, size_t ws_size, hipStream_t stream) {
    static int grid = 0;
    if (grid == 0) {
        if (n_in != 14 || ws_size < WS_END) { fprintf(stderr, "kernel_launch: unexpected inputs (n_in %d, ws %zu)\n", n_in, ws_size); grid = -1; return; }
        int dev = 0, cus = 0, per_cu = 0;
        hipGetDevice(&dev); hipDeviceGetAttribute(&cus, hipDeviceAttributeMultiprocessorCount, dev);
        if (hipFuncSetAttribute((const void*)fwd, hipFuncAttributeMaxDynamicSharedMemorySize, LDS_BYTES) != hipSuccess) { fprintf(stderr, "kernel_launch: hipFuncSetAttribute failed\n"); grid = -1; return; }
        hipOccupancyMaxActiveBlocksPerMultiprocessor(&per_cu, (const void*)fwd, 512, LDS_BYTES);
        (void)hipGetLastError();
        if (per_cu < 1) per_cu = 1;
        grid = cus * per_cu;
        if (grid != 256) fprintf(stderr, "kernel_launch: note: grid %d (cus %d x %d)\n", grid, cus, per_cu);
    }
    if (grid < 0) return;
    hipMemsetAsync((char*)d_ws + WS_CTL, 0, 768 * 1024, stream);
    Args a{};
    a.x = (const float*)d_in[0]; a.attn_g = (const float*)d_in[1]; a.w_in = (const float*)d_in[2]; a.w_gate_up = (const float*)d_in[3]; a.b_gate_up = (const float*)d_in[4];
    a.sb_g = (const float*)d_in[5]; a.gla_g = (const float*)d_in[6]; a.w_out = (const float*)d_in[7]; a.ffn_g = (const float*)d_in[8]; a.w_up = (const float*)d_in[9];
    a.conv_w = (const float*)d_in[10]; a.conv_b = (const float*)d_in[11]; a.w_down = (const float*)d_in[12]; a.final_g = (const float*)d_in[13];
    a.out = (float*)d_out; a.ws = (unsigned char*)d_ws;
#if ONE_LAUNCH
    a.ph_lo = 0; a.ph_hi = 8; a.coop = 1;
    void* args[] = {&a};
    hipError_t e = hipLaunchCooperativeKernel((const void*)fwd, dim3(grid), dim3(512), args, LDS_BYTES, stream);
    if (e != hipSuccess) fprintf(stderr, "cooperative launch failed: %s (grid %d)\n", hipGetErrorString(e), grid);
#else
    for (int p = 0; p < 8; ++p) { a.ph_lo = p; a.ph_hi = p + 1; a.coop = 0; hipLaunchKernelGGL(fwd, dim3(grid), dim3(512), LDS_BYTES, stream, a); }
#endif
}
```
